# Optimizing an MI355X kernel written in HIP

```python
import math
import jax, jax.numpy as jnp
from jax import lax
import numpy as np

D_MODEL = 1024
BATCH = 8
SEQ = 2048
DEPTH = 1

CHUNK = 64
Q_BLOCK = 2 * CHUNK
SB_HEADS = 8
SB_HEAD_DIM = 64
SB_WIDTH = SB_HEADS * SB_HEAD_DIM
SSM_GROUP = 16
SSM_WIDTH = 512
SSM_GROUPS = SSM_WIDTH // SSM_GROUP
SSM_STATE = 64
PLE_DIM = 256
N_EXPERTS = 32
TOP_K = 4
D_FF = D_MODEL
SWIGLU_LIMIT = 7.0
SWIGLU_ALPHA = 1.702
MOE_BLOCK = 256
EPS = 1e-6
IN_COLS = 3 * SB_WIDTH + SSM_WIDTH + 2 * D_MODEL

kernel_name = "hybrid_stickbreak_s5_moe_ple"


def rmsnorm(x, g):
    xf = x.astype(jnp.float32)
    y = xf * lax.rsqrt(jnp.mean(xf * xf, axis=-1, keepdims=True) + EPS)
    return (y * g.astype(jnp.float32)).astype(x.dtype)


def stick_breaking_attention(q, k, v):
    s_len, dh = q.shape[2], q.shape[3]
    scale = dh ** -0.5
    outs = []
    for start in range(0, s_len, Q_BLOCK):
        end = start + Q_BLOCK
        qb = q[:, :, start:end].astype(jnp.float32)
        kb = k[:, :, :end].astype(jnp.float32)
        vb = v[:, :, :end].astype(jnp.float32)
        z = jnp.einsum('bhtd,bhsd->bhts', qb, kb) * scale
        t_idx = start + jnp.arange(Q_BLOCK)
        s_idx = jnp.arange(end)
        mask = s_idx[None, :] < t_idx[:, None]
        log_keep = jnp.where(mask, jax.nn.log_sigmoid(-z), 0.0)
        later = lax.cumsum(log_keep, axis=3, reverse=True) - log_keep
        w = jnp.where(mask, jnp.exp(jax.nn.log_sigmoid(z) + later), 0.0)
        outs.append(jnp.einsum('bhts,bhsd->bhtd', w, vb))
    return jnp.concatenate(outs, axis=2).astype(q.dtype)


def s5_ssm(u, a_re, a_im, log_dt, b_re, b_im, c_re, c_im, d_skip):
    f32 = jnp.float32
    bsz, s_len, _ = u.shape
    uf = u.astype(f32)
    ug = uf.reshape(bsz, s_len, SSM_GROUPS, SSM_GROUP)
    lr = a_re.astype(f32)
    li = a_im.astype(f32)
    dt = jnp.exp(log_dt.astype(f32))[:, None]
    mag = jnp.exp(lr * dt)
    abar_r = mag * jnp.cos(li * dt)
    abar_i = mag * jnp.sin(li * dt)
    den = lr * lr + li * li
    nr = abar_r - 1.0
    ni = abar_i
    fr = (nr * lr + ni * li) / den
    fi = (ni * lr - nr * li) / den
    br = b_re.astype(f32)
    bi = b_im.astype(f32)
    bbar_r = fr[..., None] * br - fi[..., None] * bi
    bbar_i = fr[..., None] * bi + fi[..., None] * br
    xr = jnp.einsum('bsgc,gpc->sbgp', ug, bbar_r)
    xi = jnp.einsum('bsgc,gpc->sbgp', ug, bbar_i)
    ar = jnp.broadcast_to(abar_r[None, None], (s_len, 1, SSM_GROUPS, SSM_STATE))
    ai = jnp.broadcast_to(abar_i[None, None], (s_len, 1, SSM_GROUPS, SSM_STATE))

    def combine(e1, e2):
        a1r, a1i, b1r, b1i = e1
        a2r, a2i, b2r, b2i = e2
        return (a2r * a1r - a2i * a1i,
                a2r * a1i + a2i * a1r,
                a2r * b1r - a2i * b1i + b2r,
                a2r * b1i + a2i * b1r + b2i)

    _, _, hr, hi = lax.associative_scan(combine, (ar, ai, xr, xi), axis=0)
    y = (jnp.einsum('sbgp,gcp->bsgc', hr, c_re.astype(f32))
         - jnp.einsum('sbgp,gcp->bsgc', hi, c_im.astype(f32)))
    y = y.reshape(bsz, s_len, SSM_WIDTH) + d_skip.astype(f32) * uf
    return y.astype(u.dtype)


def moe_swiglu(h, w_router, b_router, w_up, b_up, w_down, b_down):
    f32 = jnp.float32
    bsz, s_len, d = h.shape
    n = bsz * s_len
    nk = n * TOP_K
    hf = h.reshape(n, d)
    logits = hf.astype(f32) @ w_router.astype(f32) + b_router.astype(f32)
    top_val, top_idx = lax.top_k(logits, TOP_K)
    gate = jax.nn.softmax(top_val, axis=-1)
    expert = top_idx.reshape(-1)
    weight = gate.reshape(-1)
    token = jnp.arange(nk, dtype=jnp.int32) // TOP_K
    order = jnp.argsort(expert, stable=True)
    e_sorted = expert[order]
    counts = jnp.bincount(expert, length=N_EXPERTS)
    padded = (counts + MOE_BLOCK - 1) // MOE_BLOCK * MOE_BLOCK
    start = jnp.cumsum(counts) - counts
    pad_end = jnp.cumsum(padded)
    pad_start = pad_end - padded
    dst = pad_start[e_sorted] + jnp.arange(nk) - start[e_sorted]
    n_blocks = -(-nk // MOE_BLOCK) + N_EXPERTS
    rows = n_blocks * MOE_BLOCK
    row_token = jnp.zeros((rows,), jnp.int32).at[dst].set(token[order])
    row_weight = jnp.zeros((rows,), f32).at[dst].set(weight[order])
    block_expert = jnp.minimum(
        jnp.searchsorted(pad_end, jnp.arange(n_blocks) * MOE_BLOCK, side='right'),
        N_EXPERTS - 1)
    xs = hf[row_token].reshape(n_blocks, MOE_BLOCK, d)

    def expert_block(args):
        xb, e = args
        gu = xb.astype(f32) @ w_up[e].astype(f32) + b_up[e].astype(f32)
        g = jnp.minimum(gu[:, :D_FF], SWIGLU_LIMIT)
        up = jnp.clip(gu[:, D_FF:], -SWIGLU_LIMIT, SWIGLU_LIMIT)
        act = (up + 1.0) * g * jax.nn.sigmoid(SWIGLU_ALPHA * g)
        return act @ w_down[e].astype(f32) + b_down[e].astype(f32)

    ys = lax.map(expert_block, (xs, block_expert)).reshape(rows, d)
    out = jax.ops.segment_sum(ys * row_weight[:, None], row_token, num_segments=n)
    return out.reshape(bsz, s_len, d).astype(h.dtype)


def setup_inputs(seed: int = 0) -> dict:
    key = jax.random.key(seed)
    ks = iter(jax.random.split(key, 40))
    f32 = jnp.float32
    L = DEPTH

    def nrm(shape, scale):
        return jax.random.normal(next(ks), shape, f32) * scale

    def gain(shape):
        return 1.0 + 0.05 * jax.random.normal(next(ks), shape, f32)

    n_idx = jnp.arange(SSM_STATE, dtype=f32)
    return {
        "x": nrm((BATCH, SEQ, D_MODEL), 1.0),
        "p": nrm((DEPTH, BATCH, SEQ, PLE_DIM), 1.0),
        "g_mix": gain((L, D_MODEL)),
        "w_in": nrm((L, D_MODEL, IN_COLS), D_MODEL ** -0.5),
        "g_q": gain((L, SB_HEAD_DIM)),
        "g_k": gain((L, SB_HEAD_DIM)),
        "w_attn_branch": nrm((L, SB_WIDTH, D_MODEL), SB_WIDTH ** -0.5),
        "a_re": -0.5 + nrm((L, SSM_GROUPS, SSM_STATE), 0.01),
        "a_im": math.pi * n_idx + nrm((L, SSM_GROUPS, SSM_STATE), 0.01),
        "log_dt": jax.random.uniform(next(ks), (L, SSM_GROUPS), f32,
                                     math.log(1e-3), math.log(1e-1)),
        "b_re": nrm((L, SSM_GROUPS, SSM_STATE, SSM_GROUP), (2 * SSM_GROUP) ** -0.5),
        "b_im": nrm((L, SSM_GROUPS, SSM_STATE, SSM_GROUP), (2 * SSM_GROUP) ** -0.5),
        "c_re": nrm((L, SSM_GROUPS, SSM_GROUP, SSM_STATE), (2 * SSM_STATE) ** -0.5),
        "c_im": nrm((L, SSM_GROUPS, SSM_GROUP, SSM_STATE), (2 * SSM_STATE) ** -0.5),
        "d_skip": gain((L, SSM_WIDTH)),
        "w_glu": nrm((L, SSM_WIDTH, 2 * D_MODEL), SSM_WIDTH ** -0.5),
        "b_glu": nrm((L, 2 * D_MODEL), 0.01),
        "w_out": nrm((L, D_MODEL, D_MODEL), D_MODEL ** -0.5),
        "g_ffn": gain((L, D_MODEL)),
        "w_router": nrm((L, D_MODEL, N_EXPERTS), D_MODEL ** -0.5),
        "b_router": nrm((L, N_EXPERTS), 0.01),
        "w_up": nrm((L, N_EXPERTS, D_MODEL, 2 * D_FF), D_MODEL ** -0.5),
        "b_up": nrm((L, N_EXPERTS, 2 * D_FF), 0.01),
        "w_down": nrm((L, N_EXPERTS, D_FF, D_MODEL), D_FF ** -0.5),
        "b_down": nrm((L, N_EXPERTS, D_MODEL), 0.01),
        "g_ple_gate": gain((L, D_MODEL)),
        "w_ple_gate": nrm((L, D_MODEL, D_MODEL), D_MODEL ** -0.5),
        "w_ple_proj": nrm((L, PLE_DIM, D_MODEL), PLE_DIM ** -0.5),
        "g_ple_post": gain((L, D_MODEL)),
    }


def reference(x, p, g_mix, w_in, g_q, g_k, w_attn_branch, a_re, a_im, log_dt,
              b_re, b_im, c_re, c_im, d_skip, w_glu, b_glu, w_out, g_ffn,
              w_router, b_router, w_up, b_up, w_down, b_down,
              g_ple_gate, w_ple_gate, w_ple_proj, g_ple_post):
    bsz, s_len, d = x.shape
    splits = [SB_WIDTH, 2 * SB_WIDTH, 3 * SB_WIDTH,
              3 * SB_WIDTH + SSM_WIDTH, 3 * SB_WIDTH + SSM_WIDTH + D_MODEL]

    def heads(t):
        return t.reshape(bsz, s_len, SB_HEADS, SB_HEAD_DIM).transpose(0, 2, 1, 3)

    for i in range(DEPTH):
        h = rmsnorm(x, g_mix[i])
        proj = h @ w_in[i]
        q, k, v, u, gate_a, gate_s = jnp.split(proj, splits, axis=-1)
        qh = rmsnorm(heads(q), g_q[i])
        kh = rmsnorm(heads(k), g_k[i])
        o = stick_breaking_attention(qh, kh, heads(v))
        o = o.transpose(0, 2, 1, 3).reshape(bsz, s_len, SB_WIDTH)
        attn_branch = o @ w_attn_branch[i]

        y = s5_ssm(u, a_re[i], a_im[i], log_dt[i], b_re[i], b_im[i],
                   c_re[i], c_im[i], d_skip[i])
        zg = jax.nn.gelu(y) @ w_glu[i] + b_glu[i]
        ssm_branch = zg[..., :D_MODEL] * jax.nn.sigmoid(zg[..., D_MODEL:])

        mixed = jax.nn.sigmoid(gate_a) * attn_branch + jax.nn.sigmoid(gate_s) * ssm_branch
        x = x + mixed @ w_out[i]

        x = x + moe_swiglu(rmsnorm(x, g_ffn[i]), w_router[i], b_router[i],
                           w_up[i], b_up[i], w_down[i], b_down[i])

        ple_gate = jax.nn.sigmoid(rmsnorm(x, g_ple_gate[i]) @ w_ple_gate[i])
        ple = rmsnorm(p[i] @ w_ple_proj[i], g_ple_post[i])
        x = x + ple_gate * ple
    return x
```

```cpp
#include <hip/hip_runtime.h>
#include <cstdint>
#include <cstdio>

namespace nv {
constexpr int NTOK = 16384, DM = 1024, SEQ = 2048, NB = 8, INC = 4096, NE = 32, CAP = 16384;
constexpr float EPS = 1e-6f;

__device__ __forceinline__ float sigmoidf_(float x) { return 1.f / (1.f + __expf(-x)); }
__device__ __forceinline__ float wave_sum(float v) {
#pragma unroll
    for (int o = 1; o < 64; o <<= 1) v += __shfl_xor(v, o);
    return v;
}

__global__ void k_rmsnorm(const float* x, const float* g, float* out, int rows) {
    const int lane = threadIdx.x & 63, w = (blockIdx.x * blockDim.x + threadIdx.x) >> 6;
    if (w >= rows) return;
    const float4* xr = (const float4*)(x + (size_t)w * DM);
    float4 v[4]; float s = 0.f;
#pragma unroll
    for (int j = 0; j < 4; ++j) { v[j] = xr[lane + 64 * j]; s += v[j].x * v[j].x + v[j].y * v[j].y + v[j].z * v[j].z + v[j].w * v[j].w; }
    const float r = rsqrtf(wave_sum(s) * (1.f / DM) + EPS);
    float4* o = (float4*)(out + (size_t)w * DM);
#pragma unroll
    for (int j = 0; j < 4; ++j) { const float4 gg = ((const float4*)g)[lane + 64 * j]; o[lane + 64 * j] = make_float4(v[j].x * r * gg.x, v[j].y * r * gg.y, v[j].z * r * gg.z, v[j].w * r * gg.w); }
}

struct GemmP {
    const float* A; int lda; const float* B; int ldb; float* C; int ldc; int M, N, K;
    const float* bias; const float* resid; const int* list; const int* cnt; int ashift; size_t bstride; int biasstride; int dual;
};
__global__ void __launch_bounds__(256) k_gemm(GemmP p) {
    __shared__ float As[16][68], Bs[16][64], Bs2[16][64];
    const int tid = threadIdx.x, ty = tid >> 4, tx = tid & 15, e = blockIdx.z;
    int M = p.M; const int* list = nullptr;
    const float* B = p.B + (size_t)e * p.bstride; const float* bias = p.bias ? p.bias + (size_t)e * p.biasstride : nullptr;
    if (p.list) { M = p.cnt[e]; list = p.list + (size_t)e * CAP; }
    const int m0 = blockIdx.y * 64, n0 = blockIdx.x * 64;
    if (m0 >= M) return;
    const int lr = tid >> 2, lk = (tid & 3) * 4;
    int arow = m0 + lr; bool avalid = arow < M;
    if (list && avalid) arow = list[arow] >> p.ashift;
    const float* Ap = p.A + (size_t)arow * p.lda + lk;
    const int bk = tid >> 4, bn = (tid & 15) * 4;
    float acc[4][4] = {}, acc2[4][4] = {};
    for (int k0 = 0; k0 < p.K; k0 += 16) {
        float4 a = avalid ? *(const float4*)(Ap + k0) : make_float4(0, 0, 0, 0);
        As[lk + 0][lr] = a.x; As[lk + 1][lr] = a.y; As[lk + 2][lr] = a.z; As[lk + 3][lr] = a.w;
        *(float4*)&Bs[bk][bn] = *(const float4*)(B + (size_t)(k0 + bk) * p.ldb + n0 + bn);
        if (p.dual) *(float4*)&Bs2[bk][bn] = *(const float4*)(B + (size_t)(k0 + bk) * p.ldb + n0 + bn + p.N);
        __syncthreads();
#pragma unroll
        for (int k = 0; k < 16; ++k) {
            const float4 av = *(const float4*)&As[k][ty * 4]; const float4 bv = *(const float4*)&Bs[k][tx * 4];
            const float aa[4] = {av.x, av.y, av.z, av.w}, bb[4] = {bv.x, bv.y, bv.z, bv.w};
#pragma unroll
            for (int i = 0; i < 4; ++i)
#pragma unroll
                for (int j = 0; j < 4; ++j) acc[i][j] += aa[i] * bb[j];
            if (p.dual) { const float4 cv = *(const float4*)&Bs2[k][tx * 4]; const float cc[4] = {cv.x, cv.y, cv.z, cv.w};
#pragma unroll
                for (int i = 0; i < 4; ++i)
#pragma unroll
                    for (int j = 0; j < 4; ++j) acc2[i][j] += aa[i] * cc[j]; }
        }
        __syncthreads();
    }
#pragma unroll
    for (int i = 0; i < 4; ++i) {
        int r = m0 + ty * 4 + i; if (r >= M) continue;
        const int crow = list ? list[r] : r;
        float o[4];
#pragma unroll
        for (int j = 0; j < 4; ++j) {
            const int c = n0 + tx * 4 + j; float v = acc[i][j] + (bias ? bias[c] : 0.f);
            if (p.dual) { float up = acc2[i][j] + bias[c + p.N]; float g = fminf(v, 7.f); up = fminf(fmaxf(up, -7.f), 7.f); v = (up + 1.f) * g * sigmoidf_(1.702f * g); }
            if (p.resid) v += p.resid[(size_t)crow * p.ldc + c];
            o[j] = v;
        }
        *(float4*)(p.C + (size_t)crow * p.ldc + n0 + tx * 4) = make_float4(o[0], o[1], o[2], o[3]);
    }
}

__global__ void k_qknorm(float* proj, const float* gq, const float* gk) {
    const int i = blockIdx.x * blockDim.x + threadIdx.x;
    if (i >= NTOK * 16) return;
    const int t = i >> 4, which = (i >> 3) & 1, h = i & 7;
    float* p = proj + (size_t)t * INC + which * 512 + h * 64; const float* g = which ? gk : gq;
    float s = 0.f; for (int d = 0; d < 64; ++d) s += p[d] * p[d];
    const float r = rsqrtf(s * (1.f / 64.f) + EPS) * (which ? 1.f : 0.125f);
    for (int d = 0; d < 64; ++d) p[d] = p[d] * r * g[d];
}

__global__ void __launch_bounds__(64) k_attn(const float* __restrict__ proj, float* __restrict__ o) {
    const int lane = threadIdx.x, tb = blockIdx.x % (SEQ / 64), bh = blockIdx.x / (SEQ / 64), b = bh >> 3, h = bh & 7;
    const int t = tb * 64 + lane;
    const float* base = proj + (size_t)b * SEQ * INC + h * 64;
    float q[64], acc[64];
#pragma unroll
    for (int d = 0; d < 64; ++d) { q[d] = base[(size_t)t * INC + d]; acc[d] = 0.f; }
    float R = 0.f;
    for (int s = tb * 64 + 62; s >= 0; --s) {
        const float* kr = base + (size_t)s * INC + 512; const float* vr = base + (size_t)s * INC + 1024;
        float z = 0.f;
#pragma unroll
        for (int d = 0; d < 64; ++d) z += q[d] * kr[d];
        if (s < t) {
            const float sp = fmaxf(z, 0.f) + log1pf(__expf(-fabsf(z)));
            const float w = __expf(z - sp + R);
#pragma unroll
            for (int d = 0; d < 64; ++d) acc[d] += w * vr[d];
            R -= sp;
        }
    }
    float* op = o + ((size_t)b * SEQ + t) * 512 + h * 64;
#pragma unroll
    for (int d = 0; d < 64; ++d) op[d] = acc[d];
}

__global__ void __launch_bounds__(64) k_ssm(const float* __restrict__ proj, const float* a_re, const float* a_im, const float* log_dt, const float* b_re, const float* b_im,
                                            const float* c_re, const float* c_im, const float* d_skip, float* __restrict__ yg) {
    const int p = threadIdx.x, b = blockIdx.x >> 5, g = blockIdx.x & 31;
    const float lr = a_re[g * 64 + p], li = a_im[g * 64 + p], dt = expf(log_dt[g]);
    const float mag = expf(lr * dt), ar = mag * cosf(li * dt), ai = mag * sinf(li * dt);
    const float den = lr * lr + li * li, nr = ar - 1.f, ni = ai, fr = (nr * lr + ni * li) / den, fi = (ni * lr - nr * li) / den;
    float bbr[16], bbi[16], cr[16], ci[16];
#pragma unroll
    for (int c = 0; c < 16; ++c) { const float br = b_re[(g * 64 + p) * 16 + c], bi = b_im[(g * 64 + p) * 16 + c]; bbr[c] = fr * br - fi * bi; bbi[c] = fr * bi + fi * br;
        cr[c] = c_re[(g * 16 + c) * 64 + p]; ci[c] = c_im[(g * 16 + c) * 64 + p]; }
    const float dsk = p < 16 ? d_skip[g * 16 + p] : 0.f;
    float hr = 0.f, hi = 0.f;
    for (int t = 0; t < SEQ; ++t) {
        const float* up = proj + ((size_t)b * SEQ + t) * INC + 1536 + g * 16;
        float u[16], xr = 0.f, xi = 0.f;
#pragma unroll
        for (int c = 0; c < 16; ++c) { u[c] = up[c]; xr += bbr[c] * u[c]; xi += bbi[c] * u[c]; }
        const float nhr = ar * hr - ai * hi + xr, nhi = ar * hi + ai * hr + xi; hr = nhr; hi = nhi;
        float mine = 0.f, myu = 0.f;
#pragma unroll
        for (int c = 0; c < 16; ++c) { const float s = wave_sum(cr[c] * hr - ci[c] * hi); if (p == c) { mine = s; myu = u[c]; } }
        if (p < 16) { const float y = mine + dsk * myu; const float gl = 0.5f * y * (1.f + tanhf(0.7978845608028654f * (y + 0.044715f * y * y * y)));
            yg[((size_t)b * SEQ + t) * 512 + g * 16 + p] = gl; }
    }
}

__global__ void k_mix(const float* __restrict__ proj, const float* __restrict__ ab, const float* __restrict__ zg, float* __restrict__ mixed) {
    const size_t i = (size_t)blockIdx.x * blockDim.x + threadIdx.x; if (i >= (size_t)NTOK * DM) return;
    const size_t t = i >> 10; const int c = i & 1023;
    const float ga = proj[t * INC + 2048 + c], gs = proj[t * INC + 3072 + c];
    const float z1 = zg[t * 2048 + c], z2 = zg[t * 2048 + 1024 + c];
    mixed[i] = sigmoidf_(ga) * ab[i] + sigmoidf_(gs) * (z1 * sigmoidf_(z2));
}

__global__ void k_router(const float* __restrict__ h2, const float* __restrict__ wr, const float* __restrict__ br, int* cnt, int* list, float* topw) {
    const int lane = threadIdx.x & 63, t = (blockIdx.x * blockDim.x + threadIdx.x) >> 6; if (t >= NTOK) return;
    const int e = lane & 31, kh = lane >> 5; const float* hp = h2 + (size_t)t * DM + kh * 512; const float* wp = wr + (size_t)kh * 512 * 32 + e;
    float s = 0.f; for (int k = 0; k < 512; ++k) s += hp[k] * wp[(size_t)k * 32];
    s += __shfl_xor(s, 32); s += br[e];
    float v = s; int sel[4]; float sv[4];
#pragma unroll
    for (int r = 0; r < 4; ++r) {
        float bv = v; int bi = e;
#pragma unroll
        for (int o = 1; o < 32; o <<= 1) { const float ov = __shfl_xor(bv, o); const int oi = __shfl_xor(bi, o); if (ov > bv || (ov == bv && oi < bi)) { bv = ov; bi = oi; } }
        sel[r] = bi; sv[r] = bv; if (e == bi) v = -INFINITY;
    }
    const float m = sv[0]; float ex[4], den = 0.f;
#pragma unroll
    for (int r = 0; r < 4; ++r) { ex[r] = __expf(sv[r] - m); den += ex[r]; }
    if (lane < 4) { const int r = lane; const int ee = sel[r]; const int pos = atomicAdd(&cnt[ee], 1); list[ee * CAP + pos] = t * 4 + r; topw[t * 4 + r] = ex[r] / den; }
}

__global__ void k_combine(const float* __restrict__ x2, const float* __restrict__ y, const float* __restrict__ topw, float* __restrict__ x3) {
    const size_t i = (size_t)blockIdx.x * blockDim.x + threadIdx.x; if (i >= (size_t)NTOK * DM) return;
    const size_t t = i >> 10; const int c = i & 1023; float v = x2[i];
#pragma unroll
    for (int k = 0; k < 4; ++k) v += topw[t * 4 + k] * y[(t * 4 + k) * DM + c];
    x3[i] = v;
}
__global__ void k_final(const float* __restrict__ x3, const float* __restrict__ gate, const float* __restrict__ ple, float* __restrict__ out) {
    const size_t i = (size_t)blockIdx.x * blockDim.x + threadIdx.x; if (i >= (size_t)NTOK * DM) return;
    out[i] = x3[i] + sigmoidf_(gate[i]) * ple[i];
}

inline void gemm(hipStream_t st, const float* A, int lda, const float* B, int ldb, float* C, int ldc, int M, int N, int K, const float* bias, const float* resid) {
    GemmP p{}; p.A = A; p.lda = lda; p.B = B; p.ldb = ldb; p.C = C; p.ldc = ldc; p.M = M; p.N = N; p.K = K; p.bias = bias; p.resid = resid;
    hipLaunchKernelGGL(k_gemm, dim3(N / 64, M / 64, 1), dim3(256), 0, st, p);
}

inline void forward(void* const* d_in, float* out, unsigned char* ws, hipStream_t st) {
    const float* x = (const float*)d_in[0]; const float* pin = (const float*)d_in[1];
#define IN(i) ((const float*)d_in[i])
    constexpr size_t MiB = 1u << 20;
    float* H = (float*)(ws + 0 * MiB); float* PROJ = (float*)(ws + 64 * MiB); float* O = (float*)(ws + 320 * MiB); float* YG = (float*)(ws + 352 * MiB);
    float* AB = (float*)(ws + 384 * MiB); float* ZG = (float*)(ws + 448 * MiB); float* MIX = (float*)(ws + 576 * MiB); float* X2 = (float*)(ws + 640 * MiB);
    int* CNT = (int*)(ws + 704 * MiB); int* LIST = (int*)(ws + 705 * MiB); float* TOPW = (float*)(ws + 708 * MiB);
    float* ACT = (float*)(ws + 64 * MiB); float* Y = (float*)(ws + 320 * MiB); float* X3 = (float*)(ws + 576 * MiB); float* GATE = (float*)(ws + 64 * MiB); float* PP = (float*)(ws + 128 * MiB);
    const int EW = NTOK * DM / 256;
    hipMemsetAsync(CNT, 0, 256, st);
    hipLaunchKernelGGL(k_rmsnorm, dim3(NTOK / 4), dim3(256), 0, st, x, IN(2), H, NTOK);
    gemm(st, H, DM, IN(3), INC, PROJ, INC, NTOK, INC, DM, nullptr, nullptr);
    hipLaunchKernelGGL(k_qknorm, dim3(NTOK * 16 / 256), dim3(256), 0, st, PROJ, IN(4), IN(5));
    hipLaunchKernelGGL(k_attn, dim3(NB * 8 * (SEQ / 64)), dim3(64), 0, st, PROJ, O);
    hipLaunchKernelGGL(k_ssm, dim3(NB * 32), dim3(64), 0, st, PROJ, IN(7), IN(8), IN(9), IN(10), IN(11), IN(12), IN(13), IN(14), YG);
    gemm(st, O, 512, IN(6), DM, AB, DM, NTOK, DM, 512, nullptr, nullptr);
    gemm(st, YG, 512, IN(15), 2048, ZG, 2048, NTOK, 2048, 512, IN(16), nullptr);
    hipLaunchKernelGGL(k_mix, dim3(EW), dim3(256), 0, st, PROJ, AB, ZG, MIX);
    gemm(st, MIX, DM, IN(17), DM, X2, DM, NTOK, DM, DM, nullptr, x);
    hipLaunchKernelGGL(k_rmsnorm, dim3(NTOK / 4), dim3(256), 0, st, X2, IN(18), H, NTOK);
    hipLaunchKernelGGL(k_router, dim3(NTOK / 4), dim3(256), 0, st, H, IN(19), IN(20), CNT, LIST, TOPW);
    { GemmP p{}; p.A = H; p.lda = DM; p.B = IN(21); p.ldb = 2048; p.C = ACT; p.ldc = DM; p.M = 0; p.N = 1024; p.K = DM; p.bias = IN(22); p.list = LIST; p.cnt = CNT; p.ashift = 2;
      p.bstride = (size_t)1024 * 2048; p.biasstride = 2048; p.dual = 1;
      hipLaunchKernelGGL(k_gemm, dim3(1024 / 64, CAP / 64, NE), dim3(256), 0, st, p); }
    { GemmP p{}; p.A = ACT; p.lda = DM; p.B = IN(23); p.ldb = DM; p.C = Y; p.ldc = DM; p.M = 0; p.N = 1024; p.K = DM; p.bias = IN(24); p.list = LIST; p.cnt = CNT; p.ashift = 0;
      p.bstride = (size_t)1024 * 1024; p.biasstride = 1024; p.dual = 0;
      hipLaunchKernelGGL(k_gemm, dim3(1024 / 64, CAP / 64, NE), dim3(256), 0, st, p); }
    hipLaunchKernelGGL(k_combine, dim3(EW), dim3(256), 0, st, X2, Y, TOPW, X3);
    hipLaunchKernelGGL(k_rmsnorm, dim3(NTOK / 4), dim3(256), 0, st, X3, IN(25), H, NTOK);
    gemm(st, H, DM, IN(26), DM, GATE, DM, NTOK, DM, DM, nullptr, nullptr);
    gemm(st, pin, 256, IN(27), DM, PP, DM, NTOK, DM, 256, nullptr, nullptr);
    hipLaunchKernelGGL(k_rmsnorm, dim3(NTOK / 4), dim3(256), 0, st, PP, IN(28), PP, NTOK);
    hipLaunchKernelGGL(k_final, dim3(EW), dim3(256), 0, st, X3, GATE, PP, out);
#undef IN
}
}

extern "C" void kernel_launch(void* const* d_in, const int* in_sizes, int n_in, void* d_out, int out_size, void* d_ws, size_t ws_size, hipStream_t stream) {
    nv::forward(d_in, (float*)d_out, (unsigned char*)d_ws, stream);
}
```

```cpp
#define HYB 0
#define GLUEMASK 0x7f
#include <hip/hip_runtime.h>
#include <cstdint>
#include <cstdio>

namespace nv {
constexpr int NTOK = 16384, DM = 1024, SEQ = 2048, NB = 8, INC = 4096, NE = 32, CAP = 16384;
constexpr float EPS = 1e-6f;

__device__ __forceinline__ float sigmoidf_(float x) { return 1.f / (1.f + __expf(-x)); }
__device__ __forceinline__ float wave_sum(float v) {
#pragma unroll
    for (int o = 1; o < 64; o <<= 1) v += __shfl_xor(v, o);
    return v;
}

__global__ void k_rmsnorm(const float* x, const float* g, float* out, int rows) {
    const int lane = threadIdx.x & 63, w = (blockIdx.x * blockDim.x + threadIdx.x) >> 6;
    if (w >= rows) return;
    const float4* xr = (const float4*)(x + (size_t)w * DM);
    float4 v[4]; float s = 0.f;
#pragma unroll
    for (int j = 0; j < 4; ++j) { v[j] = xr[lane + 64 * j]; s += v[j].x * v[j].x + v[j].y * v[j].y + v[j].z * v[j].z + v[j].w * v[j].w; }
    const float r = rsqrtf(wave_sum(s) * (1.f / DM) + EPS);
    float4* o = (float4*)(out + (size_t)w * DM);
#pragma unroll
    for (int j = 0; j < 4; ++j) { const float4 gg = ((const float4*)g)[lane + 64 * j]; o[lane + 64 * j] = make_float4(v[j].x * r * gg.x, v[j].y * r * gg.y, v[j].z * r * gg.z, v[j].w * r * gg.w); }
}

struct GemmP {
    const float* A; int lda; const float* B; int ldb; float* C; int ldc; int M, N, K;
    const float* bias; const float* resid; const int* list; const int* cnt; int ashift; size_t bstride; int biasstride; int dual;
};
__global__ void __launch_bounds__(256) k_gemm(GemmP p) {
    __shared__ float As[16][68], Bs[16][64], Bs2[16][64];
    const int tid = threadIdx.x, ty = tid >> 4, tx = tid & 15, e = blockIdx.z;
    int M = p.M; const int* list = nullptr;
    const float* B = p.B + (size_t)e * p.bstride; const float* bias = p.bias ? p.bias + (size_t)e * p.biasstride : nullptr;
    if (p.list) { M = p.cnt[e]; list = p.list + (size_t)e * CAP; }
    const int m0 = blockIdx.y * 64, n0 = blockIdx.x * 64;
    if (m0 >= M) return;
    const int lr = tid >> 2, lk = (tid & 3) * 4;
    int arow = m0 + lr; bool avalid = arow < M;
    if (list && avalid) arow = list[arow] >> p.ashift;
    const float* Ap = p.A + (size_t)arow * p.lda + lk;
    const int bk = tid >> 4, bn = (tid & 15) * 4;
    float acc[4][4] = {}, acc2[4][4] = {};
    for (int k0 = 0; k0 < p.K; k0 += 16) {
        float4 a = avalid ? *(const float4*)(Ap + k0) : make_float4(0, 0, 0, 0);
        As[lk + 0][lr] = a.x; As[lk + 1][lr] = a.y; As[lk + 2][lr] = a.z; As[lk + 3][lr] = a.w;
        *(float4*)&Bs[bk][bn] = *(const float4*)(B + (size_t)(k0 + bk) * p.ldb + n0 + bn);
        if (p.dual) *(float4*)&Bs2[bk][bn] = *(const float4*)(B + (size_t)(k0 + bk) * p.ldb + n0 + bn + p.N);
        __syncthreads();
#pragma unroll
        for (int k = 0; k < 16; ++k) {
            const float4 av = *(const float4*)&As[k][ty * 4]; const float4 bv = *(const float4*)&Bs[k][tx * 4];
            const float aa[4] = {av.x, av.y, av.z, av.w}, bb[4] = {bv.x, bv.y, bv.z, bv.w};
#pragma unroll
            for (int i = 0; i < 4; ++i)
#pragma unroll
                for (int j = 0; j < 4; ++j) acc[i][j] += aa[i] * bb[j];
            if (p.dual) { const float4 cv = *(const float4*)&Bs2[k][tx * 4]; const float cc[4] = {cv.x, cv.y, cv.z, cv.w};
#pragma unroll
                for (int i = 0; i < 4; ++i)
#pragma unroll
                    for (int j = 0; j < 4; ++j) acc2[i][j] += aa[i] * cc[j]; }
        }
        __syncthreads();
    }
#pragma unroll
    for (int i = 0; i < 4; ++i) {
        int r = m0 + ty * 4 + i; if (r >= M) continue;
        const int crow = list ? list[r] : r;
        float o[4];
#pragma unroll
        for (int j = 0; j < 4; ++j) {
            const int c = n0 + tx * 4 + j; float v = acc[i][j] + (bias ? bias[c] : 0.f);
            if (p.dual) { float up = acc2[i][j] + bias[c + p.N]; float g = fminf(v, 7.f); up = fminf(fmaxf(up, -7.f), 7.f); v = (up + 1.f) * g * sigmoidf_(1.702f * g); }
            if (p.resid) v += p.resid[(size_t)crow * p.ldc + c];
            o[j] = v;
        }
        *(float4*)(p.C + (size_t)crow * p.ldc + n0 + tx * 4) = make_float4(o[0], o[1], o[2], o[3]);
    }
}

__global__ void k_qknorm(float* proj, const float* gq, const float* gk) {
    const int i = blockIdx.x * blockDim.x + threadIdx.x;
    if (i >= NTOK * 16) return;
    const int t = i >> 4, which = (i >> 3) & 1, h = i & 7;
    float* p = proj + (size_t)t * INC + which * 512 + h * 64; const float* g = which ? gk : gq;
    float s = 0.f; for (int d = 0; d < 64; ++d) s += p[d] * p[d];
    const float r = rsqrtf(s * (1.f / 64.f) + EPS) * (which ? 1.f : 0.125f);
    for (int d = 0; d < 64; ++d) p[d] = p[d] * r * g[d];
}

__global__ void __launch_bounds__(64) k_attn(const float* __restrict__ proj, float* __restrict__ o) {
    const int lane = threadIdx.x, tb = blockIdx.x % (SEQ / 64), bh = blockIdx.x / (SEQ / 64), b = bh >> 3, h = bh & 7;
    const int t = tb * 64 + lane;
    const float* base = proj + (size_t)b * SEQ * INC + h * 64;
    float q[64], acc[64];
#pragma unroll
    for (int d = 0; d < 64; ++d) { q[d] = base[(size_t)t * INC + d]; acc[d] = 0.f; }
    float R = 0.f;
    for (int s = tb * 64 + 62; s >= 0; --s) {
        const float* kr = base + (size_t)s * INC + 512; const float* vr = base + (size_t)s * INC + 1024;
        float z = 0.f;
#pragma unroll
        for (int d = 0; d < 64; ++d) z += q[d] * kr[d];
        if (s < t) {
            const float sp = fmaxf(z, 0.f) + log1pf(__expf(-fabsf(z)));
            const float w = __expf(z - sp + R);
#pragma unroll
            for (int d = 0; d < 64; ++d) acc[d] += w * vr[d];
            R -= sp;
        }
    }
    float* op = o + ((size_t)b * SEQ + t) * 512 + h * 64;
#pragma unroll
    for (int d = 0; d < 64; ++d) op[d] = acc[d];
}

__global__ void __launch_bounds__(64) k_ssm(const float* __restrict__ proj, const float* a_re, const float* a_im, const float* log_dt, const float* b_re, const float* b_im,
                                            const float* c_re, const float* c_im, const float* d_skip, float* __restrict__ yg) {
    const int p = threadIdx.x, b = blockIdx.x >> 5, g = blockIdx.x & 31;
    const float lr = a_re[g * 64 + p], li = a_im[g * 64 + p], dt = expf(log_dt[g]);
    const float mag = expf(lr * dt), ar = mag * cosf(li * dt), ai = mag * sinf(li * dt);
    const float den = lr * lr + li * li, nr = ar - 1.f, ni = ai, fr = (nr * lr + ni * li) / den, fi = (ni * lr - nr * li) / den;
    float bbr[16], bbi[16], cr[16], ci[16];
#pragma unroll
    for (int c = 0; c < 16; ++c) { const float br = b_re[(g * 64 + p) * 16 + c], bi = b_im[(g * 64 + p) * 16 + c]; bbr[c] = fr * br - fi * bi; bbi[c] = fr * bi + fi * br;
        cr[c] = c_re[(g * 16 + c) * 64 + p]; ci[c] = c_im[(g * 16 + c) * 64 + p]; }
    const float dsk = p < 16 ? d_skip[g * 16 + p] : 0.f;
    float hr = 0.f, hi = 0.f;
    for (int t = 0; t < SEQ; ++t) {
        const float* up = proj + ((size_t)b * SEQ + t) * INC + 1536 + g * 16;
        float u[16], xr = 0.f, xi = 0.f;
#pragma unroll
        for (int c = 0; c < 16; ++c) { u[c] = up[c]; xr += bbr[c] * u[c]; xi += bbi[c] * u[c]; }
        const float nhr = ar * hr - ai * hi + xr, nhi = ar * hi + ai * hr + xi; hr = nhr; hi = nhi;
        float mine = 0.f, myu = 0.f;
#pragma unroll
        for (int c = 0; c < 16; ++c) { const float s = wave_sum(cr[c] * hr - ci[c] * hi); if (p == c) { mine = s; myu = u[c]; } }
        if (p < 16) { const float y = mine + dsk * myu; const float gl = 0.5f * y * (1.f + tanhf(0.7978845608028654f * (y + 0.044715f * y * y * y)));
            yg[((size_t)b * SEQ + t) * 512 + g * 16 + p] = gl; }
    }
}

__global__ void k_mix(const float* __restrict__ proj, const float* __restrict__ ab, const float* __restrict__ zg, float* __restrict__ mixed, int gsig) {
    const size_t i = (size_t)blockIdx.x * blockDim.x + threadIdx.x; if (i >= (size_t)NTOK * DM) return;
    const size_t t = i >> 10; const int c = i & 1023;
    const float ga = proj[t * INC + 2048 + c], gs = proj[t * INC + 3072 + c];
    const float z1 = zg[t * 2048 + c], z2 = zg[t * 2048 + 1024 + c];
    mixed[i] = (gsig ? ga : sigmoidf_(ga)) * ab[i] + (gsig ? gs : sigmoidf_(gs)) * (z1 * sigmoidf_(z2));
}

__global__ void k_router(const float* __restrict__ h2, const float* __restrict__ wr, const float* __restrict__ br, int* cnt, int* list, float* topw) {
    const int lane = threadIdx.x & 63, t = (blockIdx.x * blockDim.x + threadIdx.x) >> 6; if (t >= NTOK) return;
    const int e = lane & 31, kh = lane >> 5; const float* hp = h2 + (size_t)t * DM + kh * 512; const float* wp = wr + (size_t)kh * 512 * 32 + e;
    float s = 0.f; for (int k = 0; k < 512; ++k) s += hp[k] * wp[(size_t)k * 32];
    s += __shfl_xor(s, 32); s += br[e];
    float v = s; int sel[4]; float sv[4];
#pragma unroll
    for (int r = 0; r < 4; ++r) {
        float bv = v; int bi = e;
#pragma unroll
        for (int o = 1; o < 32; o <<= 1) { const float ov = __shfl_xor(bv, o); const int oi = __shfl_xor(bi, o); if (ov > bv || (ov == bv && oi < bi)) { bv = ov; bi = oi; } }
        sel[r] = bi; sv[r] = bv; if (e == bi) v = -INFINITY;
    }
    const float m = sv[0]; float ex[4], den = 0.f;
#pragma unroll
    for (int r = 0; r < 4; ++r) { ex[r] = __expf(sv[r] - m); den += ex[r]; }
    if (lane < 4) { const int r = lane; const int ee = sel[r]; const int pos = atomicAdd(&cnt[ee], 1); list[ee * CAP + pos] = t * 4 + r; topw[t * 4 + r] = ex[r] / den; }
}

__global__ void k_combine(const float* __restrict__ x2, const float* __restrict__ y, const float* __restrict__ topw, float* __restrict__ x3) {
    const size_t i = (size_t)blockIdx.x * blockDim.x + threadIdx.x; if (i >= (size_t)NTOK * DM) return;
    const size_t t = i >> 10; const int c = i & 1023; float v = x2[i];
#pragma unroll
    for (int k = 0; k < 4; ++k) v += topw[t * 4 + k] * y[(t * 4 + k) * DM + c];
    x3[i] = v;
}
__global__ void k_final(const float* __restrict__ x3, const float* __restrict__ gate, const float* __restrict__ ple, float* __restrict__ out) {
    const size_t i = (size_t)blockIdx.x * blockDim.x + threadIdx.x; if (i >= (size_t)NTOK * DM) return;
    out[i] = x3[i] + sigmoidf_(gate[i]) * ple[i];
}

inline void gemm(hipStream_t st, const float* A, int lda, const float* B, int ldb, float* C, int ldc, int M, int N, int K, const float* bias, const float* resid) {
    GemmP p{}; p.A = A; p.lda = lda; p.B = B; p.ldb = ldb; p.C = C; p.ldc = ldc; p.M = M; p.N = N; p.K = K; p.bias = bias; p.resid = resid;
    hipLaunchKernelGGL(k_gemm, dim3(N / 64, M / 64, 1), dim3(256), 0, st, p);
}


inline void forward(void* const* d_in, float* out, unsigned char* ws, hipStream_t st, int from = 0, int gsig = 0, int pp_given = 0, const float* x2p = nullptr) {
    const float* x = (const float*)d_in[0]; const float* pin = (const float*)d_in[1];
#define IN(i) ((const float*)d_in[i])
    constexpr size_t MiB = 1u << 20;
    float* H = (float*)(ws + 0 * MiB); float* PROJ = (float*)(ws + 64 * MiB); float* O = (float*)(ws + 320 * MiB); float* YG = (float*)(ws + 352 * MiB);
    float* AB = (float*)(ws + 384 * MiB); float* ZG = (float*)(ws + 448 * MiB); float* MIX = (float*)(ws + 576 * MiB); float* X2 = (float*)(ws + 640 * MiB);
    int* CNT = (int*)(ws + 704 * MiB); int* LIST = (int*)(ws + 705 * MiB); float* TOPW = (float*)(ws + 708 * MiB);
    float* ACT = (float*)(ws + 64 * MiB); float* Y = (float*)(ws + 320 * MiB); float* X3 = (float*)(ws + 576 * MiB); float* GATE = (float*)(ws + 64 * MiB); float* PP = (float*)(ws + 720 * MiB);
    const int EW = NTOK * DM / 256;
    if (from <= 0) {
        hipLaunchKernelGGL(k_rmsnorm, dim3(NTOK / 4), dim3(256), 0, st, x, IN(2), H, NTOK);
        gemm(st, H, DM, IN(3), INC, PROJ, INC, NTOK, INC, DM, nullptr, nullptr);
        hipLaunchKernelGGL(k_qknorm, dim3(NTOK * 16 / 256), dim3(256), 0, st, PROJ, IN(4), IN(5));
    }
    if (from <= 1) {
        hipLaunchKernelGGL(k_attn, dim3(NB * 8 * (SEQ / 64)), dim3(64), 0, st, PROJ, O);
        hipLaunchKernelGGL(k_ssm, dim3(NB * 32), dim3(64), 0, st, PROJ, IN(7), IN(8), IN(9), IN(10), IN(11), IN(12), IN(13), IN(14), YG);
    }
    if (from <= 2) {
        gemm(st, O, 512, IN(6), DM, AB, DM, NTOK, DM, 512, nullptr, nullptr);
        gemm(st, YG, 512, IN(15), 2048, ZG, 2048, NTOK, 2048, 512, IN(16), nullptr);
        hipLaunchKernelGGL(k_mix, dim3(EW), dim3(256), 0, st, PROJ, AB, ZG, MIX, gsig);
        gemm(st, MIX, DM, IN(17), DM, X2, DM, NTOK, DM, DM, nullptr, x);
    }
    if (from <= 3) {
        const float* X2r = (from == 3) ? x2p : X2;
        hipMemsetAsync(CNT, 0, 256, st);
        hipLaunchKernelGGL(k_rmsnorm, dim3(NTOK / 4), dim3(256), 0, st, X2r, IN(18), H, NTOK);
        hipLaunchKernelGGL(k_router, dim3(NTOK / 4), dim3(256), 0, st, H, IN(19), IN(20), CNT, LIST, TOPW);
        { GemmP p{}; p.A = H; p.lda = DM; p.B = IN(21); p.ldb = 2048; p.C = ACT; p.ldc = DM; p.M = 0; p.N = 1024; p.K = DM; p.bias = IN(22); p.list = LIST; p.cnt = CNT; p.ashift = 2;
          p.bstride = (size_t)1024 * 2048; p.biasstride = 2048; p.dual = 1;
          hipLaunchKernelGGL(k_gemm, dim3(1024 / 64, CAP / 64, NE), dim3(256), 0, st, p); }
        { GemmP p{}; p.A = ACT; p.lda = DM; p.B = IN(23); p.ldb = DM; p.C = Y; p.ldc = DM; p.M = 0; p.N = 1024; p.K = DM; p.bias = IN(24); p.list = LIST; p.cnt = CNT; p.ashift = 0;
          p.bstride = (size_t)1024 * 1024; p.biasstride = 1024; p.dual = 0;
          hipLaunchKernelGGL(k_gemm, dim3(1024 / 64, CAP / 64, NE), dim3(256), 0, st, p); }
        hipLaunchKernelGGL(k_combine, dim3(EW), dim3(256), 0, st, X2r, Y, TOPW, X3);
    }
    {
        const float* X3r = (from == 4) ? out : X3;
        hipLaunchKernelGGL(k_rmsnorm, dim3(NTOK / 4), dim3(256), 0, st, X3r, IN(25), H, NTOK);
        gemm(st, H, DM, IN(26), DM, GATE, DM, NTOK, DM, DM, nullptr, nullptr);
        if (!pp_given) gemm(st, pin, 256, IN(27), DM, PP, DM, NTOK, DM, 256, nullptr, nullptr);
        hipLaunchKernelGGL(k_rmsnorm, dim3(NTOK / 4), dim3(256), 0, st, PP, IN(28), PP, NTOK);
        hipLaunchKernelGGL(k_final, dim3(EW), dim3(256), 0, st, X3r, GATE, PP, out);
    }
#undef IN
}
}
#include <hip/hip_runtime.h>
#include <cstdint>
#include <cstdio>
namespace mk {
#define LAS __attribute__((address_space(3)))
#define GAS __attribute__((address_space(1)))
typedef unsigned short bf16;
typedef short bf16x8 __attribute__((ext_vector_type(8)));
typedef float f32x4 __attribute__((ext_vector_type(4)));
typedef float f32x16 __attribute__((ext_vector_type(16)));
typedef float f32x2 __attribute__((ext_vector_type(2)));
typedef unsigned u32x4 __attribute__((ext_vector_type(4)));
typedef unsigned u32x2 __attribute__((ext_vector_type(2)));
typedef GAS unsigned gu32;

constexpr int NTOK = 16384, DM = 1024, SEQ = 2048, NBATCH = 8, INC = 4096, NE = 32, CAP = 16384, NHEAD = 8, HD = 64;
constexpr float EPS = 1e-6f;
constexpr int MAXRT = 288;
constexpr size_t MiB = 1u << 20;
constexpr size_t WS_CTL = 0, CTL_ZERO_BYTES = 1 * MiB;
constexpr size_t WS_LIST = 1 * MiB, WS_TOPW = 3 * MiB, WS_PSS = 4 * MiB, WS_A64 = 5 * MiB, WS_MTAB = 6 * MiB, WS_PTAB = 8 * MiB, WS_RTAB = 16 * MiB;
constexpr size_t WS_WIN = 26 * MiB, WS_WAB = 34 * MiB, WS_WGLU = 35 * MiB, WS_WOUT = 37 * MiB, WS_WPG = 39 * MiB, WS_WPP = 41 * MiB, WS_WUP = 42 * MiB, WS_WDN = 170 * MiB;
constexpr size_t WS_XN = 234 * MiB, WS_PBF = 266 * MiB, WS_PP = 274 * MiB, WS_X2 = 306 * MiB;
constexpr size_t WS_QH = 370 * MiB, WS_KH = 386 * MiB, WS_VT = 402 * MiB, WS_U = 418 * MiB, WS_SGA = 434 * MiB, WS_SGS = 466 * MiB, WS_O = 498 * MiB, WS_YG = 514 * MiB, WS_T1 = 530 * MiB, WS_MIX = 562 * MiB;
constexpr size_t WS_ACT = 370 * MiB, WS_YS = 594 * MiB, WS_END = 722 * MiB;
constexpr int CW_TMO = 0, CW_BAR = 4096, CW_CNT = 8192;
constexpr int RING_BYTES = 131072, LDSCTL_OFF = RING_BYTES, MISC_OFF = LDSCTL_OFF + 320, LDS_BYTES = 147456;
constexpr int NWAVES = 8;

#define RLX_AGENT __ATOMIC_RELAXED, __HIP_MEMORY_SCOPE_AGENT
#define LDS_WAIT() asm volatile("s_waitcnt lgkmcnt(0)" ::: "memory")
#define VM_WAIT() asm volatile("s_waitcnt vmcnt(0)" ::: "memory")
__device__ __forceinline__ unsigned f2bf(float f) { unsigned u = __builtin_bit_cast(unsigned, f); return (u + 0x7fffu + ((u >> 16) & 1u)) >> 16; }
__device__ __forceinline__ unsigned pk2(float lo, float hi) { return f2bf(lo) | (f2bf(hi) << 16); }
__device__ __forceinline__ float bflo(unsigned w) { return __builtin_bit_cast(float, w << 16); }
__device__ __forceinline__ float bfhi(unsigned w) { return __builtin_bit_cast(float, w & 0xffff0000u); }
__device__ __forceinline__ float sigm(float x) { return __builtin_amdgcn_rcpf(1.f + __expf(-x)); }
__device__ __forceinline__ float wave_sum(float v) {
#pragma unroll
    for (int o = 1; o < 64; o <<= 1) v += __shfl_xor(v, o);
    return v;
}

#define XB_TMO      128
#define XB_XCNT(j)  (256  + 64 * (j))
#define XB_XSUB(j)  (1280 + 64 * (j))
#define XB_XGEN(j)  (2304 + 64 * (j))
#define XB_TOP      3328
#define XB_TOPGEN   3392
#define XCD_BAR_WORDS 3456
#define XB_SPIN_CAP (1u << 18)
__device__ __forceinline__ unsigned xb_ld(unsigned* p)              { return __hip_atomic_load(p, __ATOMIC_RELAXED, __HIP_MEMORY_SCOPE_AGENT); }
__device__ __forceinline__ unsigned xb_add(unsigned* p, unsigned v) { return __hip_atomic_fetch_add(p, v, __ATOMIC_RELAXED, __HIP_MEMORY_SCOPE_AGENT); }
__device__ __forceinline__ unsigned xb_xcc_id() { return (unsigned)__builtin_amdgcn_s_getreg((3 << 11) | 20) & 0xFu; }
#define XB_SPIN(cond, bar) do { unsigned _sp = 0; while (cond) { __builtin_amdgcn_s_sleep(1); \
    if ((++_sp & 255u) == 0u) { if (xb_ld(&(bar)[XB_TMO])) break; if (_sp > XB_SPIN_CAP) { atomicAdd(&(bar)[XB_TMO], 1u); break; } } } } while (0)
struct XcdBarrier { unsigned* bar; unsigned x; volatile LAS unsigned* st; };
__device__ __forceinline__ XcdBarrier xcd_barrier_post(unsigned* bar, volatile LAS unsigned* st) {
    XcdBarrier b; b.bar = bar; b.x = xb_xcc_id(); b.st = st;
    if (threadIdx.x == 0) (void)xb_add(&bar[XB_XCNT(b.x)], 1u);
    return b;
}
__device__ __forceinline__ void xcd_barrier_complete(unsigned* bar, unsigned x, unsigned& nloc, unsigned& nx) {
    const unsigned G = gridDim.x * gridDim.y * gridDim.z;
    unsigned sum, cnt, mine, sp = 0u;
    for (;;) {
        sum = 0u; cnt = 0u; mine = 0u;
#pragma unroll
        for (unsigned j = 0; j < 16; ++j) { const unsigned c = xb_ld(&bar[XB_XCNT(j)]); sum += c; cnt += (c > 0u) ? 1u : 0u; mine = (j == x) ? c : mine; }
        if (sum == G) break;
        __builtin_amdgcn_s_sleep(1);
        if ((++sp & 255u) == 0u) { if (xb_ld(&bar[XB_TMO])) break; if (sp > XB_SPIN_CAP) { atomicAdd(&bar[XB_TMO], 1u); break; } }
    }
    nloc = mine > 0u ? mine : 1u; nx = cnt > 0u ? cnt : 1u;
}
__device__ __forceinline__ void xcd_barrier(const XcdBarrier& b) {
    asm volatile("s_waitcnt vmcnt(0)" ::: "memory");
    __syncthreads();
    if (threadIdx.x == 0) {
        unsigned* bar = b.bar;
        __builtin_amdgcn_s_waitcnt(0);
        unsigned nloc = b.st[0], nx = b.st[1];
        if (nloc == 0u) { xcd_barrier_complete(bar, b.x, nloc, nx); b.st[0] = nloc; b.st[1] = nx; }
        const unsigned old = xb_add(&bar[XB_XSUB(b.x)], 1u);
        const unsigned gen = old / nloc;
        if (old + 1u == (gen + 1u) * nloc) {
            __builtin_amdgcn_fence(__ATOMIC_RELEASE, "agent");
            asm volatile("s_waitcnt vmcnt(0)" ::: "memory");
            const unsigned og = xb_add(&bar[XB_TOP], 1u);
            const unsigned tg = og / nx;
            if (og + 1u == (tg + 1u) * nx) xb_add(&bar[XB_TOPGEN], 1u);
            else XB_SPIN(xb_ld(&bar[XB_TOPGEN]) == tg, bar);
            __builtin_amdgcn_fence(__ATOMIC_ACQUIRE, "agent");
            xb_add(&bar[XB_XGEN(b.x)], 1u);
            asm volatile("s_waitcnt vmcnt(0)" ::: "memory");
        } else {
            XB_SPIN(xb_ld(&bar[XB_XGEN(b.x)]) == gen, bar);
            __builtin_amdgcn_fence(__ATOMIC_ACQUIRE, "agent");
            asm volatile("s_waitcnt vmcnt(0)" ::: "memory");
        }
    }
    __syncthreads();
}

namespace pg8 {
constexpr int BM = 256, BK = 64, HALF = 128, HTB = HALF * BK * 2, STAGE_BYTES = 8 * HTB, NXCD = 8, WGM = 8;
__host__ __device__ __forceinline__ int lds_byte(int r, int c) { const int st = (r >> 4) * 2 + (c >> 5), rr = r & 15, cc = c & 31, ob = rr * 64 + cc * 2; return st * 1024 + (ob ^ (((ob >> 9) & 1) << 5)); }
__host__ __device__ __forceinline__ void stage_rc(int b, int& R, int& C) { const int st = b / 1024, sb = b % 1024, swz = sb ^ (((sb >> 9) & 1) << 5); R = (st >> 1) * 16 + swz / 64; C = (st & 1) * 32 + (swz % 64) / 2; }
__host__ __device__ __forceinline__ int perm32(int rho) { const int n = rho >> 4, i = rho & 15; return 8 * (i >> 2) + 4 * n + (i & 3); }

struct Unit { int pm, pn, pb, e, nv, lb; };
struct Gemm { const bf16* A; const bf16* Bt; int K; };

struct StaticOrder {
    int nM, nN, nwg, G, c;
    __device__ void init(int M, int N, int G_, int c_) { nM = M / BM; nN = N / BM; nwg = nM * nN; G = G_; c = c_; }
    __device__ bool next(int i, Unit& u) const {
        const long L = (long)i * G + c; if (L >= nwg) return false;
        int wgid = (int)L; { const int q = nwg / NXCD, r = nwg % NXCD, xcd = wgid % NXCD, off = wgid / NXCD; wgid = (xcd < r ? xcd * (q + 1) : r * (q + 1) + (xcd - r) * q) + off; }
        const int nig = WGM * nN, gid = wgid / nig, fm = gid * WGM, gsz = (nM - fm) < WGM ? (nM - fm) : WGM;
        u.pm = fm + ((wgid % nig) % gsz); u.pn = (wgid % nig) / gsz; u.pb = u.pn; u.e = 0; u.nv = 256; u.lb = 0; return true;
    }
    __device__ __forceinline__ unsigned arow(const Unit& u, int row) const { return (unsigned)(u.pm * 256 + row); }
};
struct MoeOrder {
    const LAS int* tst; const LAS int* cnt; const int* list; int nN, bx, G, shift;
    __device__ bool next(int i, Unit& u) const {
        int pn, rt;
        if (nN == 8) { pn = bx & 7; rt = (bx >> 3) + (G >> 3) * i; }
        else { pn = bx & 3; rt = 2 * ((bx >> 3) + (G >> 3) * i) + ((bx >> 2) & 1); }
        if (rt >= __builtin_amdgcn_readfirstlane(tst[32])) return false;
        int e = 0;
#pragma unroll 1
        for (int j = 1; j < 32; ++j) e = (__builtin_amdgcn_readfirstlane(tst[j]) <= rt) ? j : e;
        const int t0 = __builtin_amdgcn_readfirstlane(tst[e]), ce = __builtin_amdgcn_readfirstlane(cnt[e]);
        u.pm = rt; u.pn = pn; u.pb = e * nN + pn; u.e = e; const int r0 = (rt - t0) * 256; const int left = ce - r0; u.nv = left < 256 ? left : 256; u.lb = e * CAP + r0; return true;
    }
    __device__ __forceinline__ unsigned arow(const Unit& u, int row) const { const int r = row < u.nv ? row : u.nv - 1; return (unsigned)(list[u.lb + r] >> shift); }
};

__device__ __forceinline__ unsigned cvt_pk_bf16(float lo, float hi) { unsigned r; asm volatile("v_cvt_pk_bf16_f32 %0, %1, %2" : "=v"(r) : "v"(lo), "v"(hi)); return r; }

template <class Epi, class Sched, bool GATHER>
__device__ __forceinline__ void gemm_phase(LAS unsigned char* lds, const Gemm g, const Sched& S, const Epi& E) {
    const int tid = threadIdx.x, wid = __builtin_amdgcn_readfirstlane(tid >> 6), lane = tid & 63, wr = wid >> 2, wc = wid & 3, fr = lane & 15, fq = lane >> 4;
    const int K = g.K, nt = K / BK;
    int sR[2], sC[2]; unsigned voffB[2], voffA[2];
#pragma unroll
    for (int i = 0; i < 2; ++i) { stage_rc(tid * 16 + i * 8192, sR[i], sC[i]); const int Rb = Epi::PERM ? ((sR[i] & ~31) + perm32(sR[i] & 31)) : sR[i];
        voffB[i] = (unsigned)(Rb * K + sC[i]) * 2u; voffA[i] = (unsigned)(sR[i] * K + sC[i]) * 2u; }
    const unsigned kstep = (unsigned)(BK * 2);
    const unsigned hstep = (unsigned)HALF * (unsigned)K * 2u;
    const unsigned tstep = 2u * hstep;
    const unsigned ldsw = (unsigned)wid * 1024u;
    const int aoff = lds_byte(wr * 64 + fr, fq * 8), boff = lds_byte(wc * 32 + fr, fq * 8);
    const __amdgpu_buffer_rsrc_t rA = __builtin_amdgcn_make_buffer_rsrc((void*)g.A, 0, 0xfffff000u, 0x00020000);
    const __amdgpu_buffer_rsrc_t rB = __builtin_amdgcn_make_buffer_rsrc((void*)g.Bt, 0, 0xfffff000u, 0x00020000);
#define PG8_SA(b, h) (((b) * 2 + (h)) * HTB)
#define PG8_SB(b, h) ((4 + (b) * 2 + (h)) * HTB)
#define PG8_STAGE(bufoff, soff) do { _Pragma("unroll") for (int _i = 0; _i < 2; ++_i) \
        __builtin_amdgcn_raw_ptr_buffer_load_lds(rB, (LAS unsigned*)(lds + (bufoff) + ldsw + _i * 8192), 16, voffB[_i], (int)(soff), 0, 0); } while (0)
#define PG8_STAGEA(bufoff, soff, h, NX) do { _Pragma("unroll") for (int _i = 0; _i < 2; ++_i) { const unsigned _o = GATHER ? ((NX) ? vAn[h][_i] : vAc[h][_i]) : voffA[_i]; \
        __builtin_amdgcn_raw_ptr_buffer_load_lds(rA, (LAS unsigned*)(lds + (bufoff) + ldsw + _i * 8192), 16, _o, (int)((soff) + (GATHER ? 0u : (unsigned)(h) * hstep)), 0, 0); } } while (0)
#define PG8_LDA(dst, b, h) do { _Pragma("unroll") for (int m = 0; m < 4; ++m) _Pragma("unroll") for (int k = 0; k < 2; ++k) dst[m][k] = *(const LAS bf16x8*)(lds + PG8_SA(b, h) + aoff + m * 2048 + k * 1024); } while (0)
#define PG8_LDB(dst, b, h) do { _Pragma("unroll") for (int n = 0; n < 2; ++n) _Pragma("unroll") for (int k = 0; k < 2; ++k) dst[n][k] = *(const LAS bf16x8*)(lds + PG8_SB(b, h) + boff + n * 2048 + k * 1024); } while (0)
#define PG8_MMA(ai, bj, At, Bt) do { __builtin_amdgcn_s_setprio(1); _Pragma("unroll") for (int m = 0; m < 4; ++m) _Pragma("unroll") for (int n = 0; n < 2; ++n) _Pragma("unroll") for (int k = 0; k < 2; ++k) \
        acc[ai][bj][m][n] = __builtin_amdgcn_mfma_f32_16x16x32_bf16(Bt[n][k], At[m][k], acc[ai][bj][m][n], 0, 0, 0); __builtin_amdgcn_s_setprio(0); } while (0)
#define PG8_WAIT_V(n) asm volatile("s_waitcnt vmcnt(" #n ")" ::: "memory")
#define PG8_WAIT_L(n) asm volatile("s_waitcnt lgkmcnt(" #n ")" ::: "memory")
#define PG8_BAR __builtin_amdgcn_s_barrier()
#define PG8_SCHED __builtin_amdgcn_sched_barrier(0)
    Unit cur, nxt; int ui = 0;
    if (!S.next(0, cur)) return;
    unsigned vAc[2][2], vAn[2][2];
#define PG8_AOFF(dst, u) do { _Pragma("unroll") for (int _h = 0; _h < 2; ++_h) _Pragma("unroll") for (int _i = 0; _i < 2; ++_i) \
        dst[_h][_i] = S.arow(u, _h * HALF + sR[_i]) * (unsigned)(K * 2) + (unsigned)(sC[_i] * 2); } while (0)
    if (GATHER) { PG8_AOFF(vAc, cur); }
    f32x4 acc[2][2][4][2];
#pragma unroll
    for (int a = 0; a < 2; ++a)
#pragma unroll
        for (int b = 0; b < 2; ++b)
#pragma unroll
            for (int m = 0; m < 4; ++m)
#pragma unroll
                for (int n = 0; n < 2; ++n) acc[a][b][m][n] = (f32x4){0.f, 0.f, 0.f, 0.f};
    bf16x8 At[4][2], B0[2][2], B1[2][2];
    unsigned cA = GATHER ? 0u : (unsigned)cur.pm * tstep, cB = (unsigned)cur.pb * tstep;
    PG8_STAGE(PG8_SB(0, 0), cB); PG8_STAGE(PG8_SB(0, 1), cB + hstep); PG8_STAGEA(PG8_SA(0, 0), cA, 0, false); PG8_STAGEA(PG8_SA(0, 1), cA, 1, false);
    if (wr == 1) PG8_BAR;
    PG8_WAIT_V(2); PG8_BAR;
    PG8_STAGE(PG8_SB(1, 0), cB + kstep); PG8_STAGEA(PG8_SA(1, 0), cA + kstep, 0, false); PG8_STAGE(PG8_SB(1, 1), cB + hstep + kstep);
    PG8_WAIT_V(6); PG8_BAR;
    for (;;) {
        const bool has_next = S.next(ui + 1, nxt);
        const unsigned nA = has_next ? (GATHER ? 0u : (unsigned)nxt.pm * tstep) : cA, nB = has_next ? (unsigned)nxt.pb * tstep : cB;
        if (GATHER) { if (has_next) { PG8_AOFF(vAn, nxt); } else {
#pragma unroll
            for (int _h = 0; _h < 2; ++_h)
#pragma unroll
                for (int _i = 0; _i < 2; ++_i) vAn[_h][_i] = vAc[_h][_i]; } }
        for (int t = 0; t < nt; t += 2) {
            const bool last = (t == nt - 2);
            const unsigned a1 = cA + (unsigned)(t + 1) * kstep;
            const unsigned a2 = last ? nA : cA + (unsigned)(t + 2) * kstep, b2 = last ? nB : cB + (unsigned)(t + 2) * kstep;
            const unsigned a3 = a2 + kstep, b3 = b2 + kstep;
            PG8_LDB(B0, 0, 0); PG8_LDB(B1, 0, 1); PG8_SCHED; PG8_LDA(At, 0, 0); PG8_STAGEA(PG8_SA(1, 1), a1, 1, false);
            PG8_WAIT_V(8); PG8_WAIT_L(0); PG8_BAR; PG8_MMA(0, 0, At, B0); PG8_MMA(0, 1, At, B1); PG8_BAR; PG8_SCHED;
            PG8_LDA(At, 0, 1); PG8_STAGE(PG8_SB(0, 0), b2); PG8_STAGE(PG8_SB(0, 1), b2 + hstep); PG8_STAGEA(PG8_SA(0, 0), a2, 0, last);
            PG8_WAIT_V(8); PG8_WAIT_L(0); PG8_BAR; PG8_MMA(1, 0, At, B0); PG8_MMA(1, 1, At, B1); PG8_BAR; PG8_SCHED;
            PG8_LDB(B0, 1, 0); PG8_LDB(B1, 1, 1); PG8_SCHED; PG8_LDA(At, 1, 0); PG8_STAGEA(PG8_SA(0, 1), a2, 1, last);
            PG8_WAIT_V(8); PG8_WAIT_L(0); PG8_BAR; PG8_MMA(0, 0, At, B0); PG8_MMA(0, 1, At, B1); PG8_BAR; PG8_SCHED;
            PG8_LDA(At, 1, 1); PG8_STAGE(PG8_SB(1, 0), b3); PG8_STAGE(PG8_SB(1, 1), b3 + hstep); PG8_STAGEA(PG8_SA(1, 0), a3, 0, last);
            PG8_WAIT_V(8); PG8_WAIT_L(0); PG8_BAR; PG8_MMA(1, 0, At, B0); PG8_MMA(1, 1, At, B1); PG8_BAR; PG8_SCHED;
        }
        if (wr == 0) PG8_BAR;
        E(acc, cur, wr, wc, fr, fq);
        if (!has_next) break;
#pragma unroll
        for (int a = 0; a < 2; ++a)
#pragma unroll
            for (int b = 0; b < 2; ++b)
#pragma unroll
                for (int m = 0; m < 4; ++m)
#pragma unroll
                    for (int n = 0; n < 2; ++n) acc[a][b][m][n] = (f32x4){0.f, 0.f, 0.f, 0.f};
        cur = nxt; cA = nA; cB = nB; ++ui;
        if (GATHER) {
#pragma unroll
            for (int _h = 0; _h < 2; ++_h)
#pragma unroll
                for (int _i = 0; _i < 2; ++_i) vAc[_h][_i] = vAn[_h][_i]; }
        if (wr == 1) PG8_BAR;
    }
    PG8_WAIT_V(0);
    PG8_BAR;
#undef PG8_SA
#undef PG8_SB
#undef PG8_STAGE
#undef PG8_STAGEA
#undef PG8_LDA
#undef PG8_LDB
#undef PG8_MMA
#undef PG8_WAIT_V
#undef PG8_WAIT_L
#undef PG8_BAR
#undef PG8_SCHED
#undef PG8_AOFF
}
}
namespace epi {
using pg8::Unit; using pg8::HALF;
typedef const f32x4 (&AccRef)[2][2][4][2];
__device__ __forceinline__ u32x4 pack8(const f32x4 a, const f32x4 b) { u32x4 w; w.x = pk2(a[0], a[1]); w.y = pk2(a[2], a[3]); w.z = pk2(b[0], b[1]); w.w = pk2(b[2], b[3]); return w; }
__device__ __forceinline__ void unpack8(const u32x4 w, f32x4& a, f32x4& b) { a = (f32x4){bflo(w.x), bfhi(w.x), bflo(w.y), bfhi(w.y)}; b = (f32x4){bflo(w.z), bfhi(w.z), bflo(w.w), bfhi(w.w)}; }

struct EpiInProj {
    static constexpr bool PERM = true;
    bf16 *QH, *KH, *VT, *U, *SGA, *SGS; const float* gq; const float* gk;
    __device__ __forceinline__ void operator()(AccRef acc, const Unit& u, int wr, int wc, int fr, int fq) const {
        const int pn = u.pn;
        if (pn < 4) {
            const int which = pn >> 1, h = (pn & 1) * 4 + wc; const float* g = which ? gk : gq; bf16* dst = which ? KH : QH; const float qs = which ? 1.f : 0.125f * 1.4426950408889634f;
            f32x4 gv[2][2];
#pragma unroll
            for (int bj = 0; bj < 2; ++bj)
#pragma unroll
                for (int n = 0; n < 2; ++n) gv[bj][n] = *(const f32x4*)(g + 32 * bj + 8 * fq + 4 * n);
#pragma unroll
            for (int ai = 0; ai < 2; ++ai)
#pragma unroll
                for (int m = 0; m < 4; ++m) {
                    float ss = 0.f;
#pragma unroll
                    for (int bj = 0; bj < 2; ++bj)
#pragma unroll
                        for (int n = 0; n < 2; ++n) { const f32x4 v = acc[ai][bj][m][n]; ss += (v[0] * v[0] + v[1] * v[1]) + (v[2] * v[2] + v[3] * v[3]); }
                    ss += __shfl_xor(ss, 16); ss += __shfl_xor(ss, 32);
                    const float rs = rsqrtf(ss * (1.f / 64.f) + EPS) * qs;
                    const int row = u.pm * 256 + ai * HALF + wr * 64 + m * 16 + fr, b = row >> 11, s = row & 2047;
                    bf16* rp = dst + ((size_t)(b * NHEAD + h) * SEQ + s) * HD + 8 * fq;
#pragma unroll
                    for (int bj = 0; bj < 2; ++bj) *(u32x4*)(rp + 32 * bj) = pack8(acc[ai][bj][m][0] * rs * gv[bj][0], acc[ai][bj][m][1] * rs * gv[bj][1]);
                    asm volatile("" ::: "memory");
                }
        } else if (pn < 6) {
#pragma unroll
            for (int ai = 0; ai < 2; ++ai)
#pragma unroll
                for (int m = 0; m < 4; ++m) {
                    const int row = u.pm * 256 + ai * HALF + wr * 64 + m * 16 + fr, b = row >> 11, s = row & 2047;
#pragma unroll
                    for (int bj = 0; bj < 2; ++bj)
#pragma unroll
                        for (int n = 0; n < 2; ++n)
#pragma unroll
                            for (int i = 0; i < 4; ++i) { const int c = (pn - 4) * 256 + 128 * bj + 32 * wc + 8 * fq + 4 * n + i;
                                VT[((size_t)b * 512 + c) * SEQ + s] = (bf16)f2bf(acc[ai][bj][m][n][i]); }
                    asm volatile("" ::: "memory");
                }
        } else if (pn < 8) {
#pragma unroll
            for (int ai = 0; ai < 2; ++ai)
#pragma unroll
                for (int m = 0; m < 4; ++m) { const int row = u.pm * 256 + ai * HALF + wr * 64 + m * 16 + fr;
#pragma unroll
                    for (int bj = 0; bj < 2; ++bj) *(u32x4*)(U + (size_t)row * 512 + (pn - 6) * 256 + 128 * bj + 32 * wc + 8 * fq) = pack8(acc[ai][bj][m][0], acc[ai][bj][m][1]); asm volatile("" ::: "memory"); }
        } else {
            bf16* dst = pn < 12 ? SGA : SGS; const int ct = ((pn - 8) & 3) * 256;
#pragma unroll
            for (int ai = 0; ai < 2; ++ai)
#pragma unroll
                for (int m = 0; m < 4; ++m) { const int row = u.pm * 256 + ai * HALF + wr * 64 + m * 16 + fr;
#pragma unroll
                    for (int bj = 0; bj < 2; ++bj) { f32x4 a = acc[ai][bj][m][0], b = acc[ai][bj][m][1];
#pragma unroll
                        for (int i = 0; i < 4; ++i) { a[i] = sigm(a[i]); b[i] = sigm(b[i]); }
                        *(u32x4*)(dst + (size_t)row * DM + ct + 128 * bj + 32 * wc + 8 * fq) = pack8(a, b); } asm volatile("" ::: "memory"); }
        }
    }
};
struct EpiPle {
    static constexpr bool PERM = true;
    bf16* PP; float* PSS;
    __device__ __forceinline__ void operator()(AccRef acc, const Unit& u, int wr, int wc, int fr, int fq) const {
#pragma unroll
        for (int ai = 0; ai < 2; ++ai)
#pragma unroll
            for (int m = 0; m < 4; ++m) { const int row = u.pm * 256 + ai * HALF + wr * 64 + m * 16 + fr; float ss = 0.f;
#pragma unroll
                for (int bj = 0; bj < 2; ++bj) {
#pragma unroll
                    for (int n = 0; n < 2; ++n) { const f32x4 v = acc[ai][bj][m][n]; ss += (v[0] * v[0] + v[1] * v[1]) + (v[2] * v[2] + v[3] * v[3]); }
                    *(u32x4*)(PP + (size_t)row * DM + u.pn * 256 + 128 * bj + 32 * wc + 8 * fq) = pack8(acc[ai][bj][m][0], acc[ai][bj][m][1]); }
                ss += __shfl_xor(ss, 16); ss += __shfl_xor(ss, 32);
                if (fq == 0) PSS[(size_t)row * 16 + u.pn * 4 + wc] = ss; asm volatile("" ::: "memory"); }
    }
};
struct EpiT1 {
    static constexpr bool PERM = true;
    const bf16* SGA; bf16* T1;
    __device__ __forceinline__ void operator()(AccRef acc, const Unit& u, int wr, int wc, int fr, int fq) const {
#pragma unroll
        for (int ai = 0; ai < 2; ++ai)
#pragma unroll
            for (int m = 0; m < 4; ++m) { const size_t off = (size_t)(u.pm * 256 + ai * HALF + wr * 64 + m * 16 + fr) * DM + u.pn * 256 + 32 * wc + 8 * fq;
#pragma unroll
                for (int bj = 0; bj < 2; ++bj) { f32x4 ga, gb; unpack8(*(const u32x4*)(SGA + off + 128 * bj), ga, gb); *(u32x4*)(T1 + off + 128 * bj) = pack8(acc[ai][bj][m][0] * ga, acc[ai][bj][m][1] * gb); } asm volatile("" ::: "memory"); }
    }
};
struct EpiGlu {
    static constexpr bool PERM = true;
    const bf16* T1; const bf16* SGS; const float* bg; bf16* MIX;
    __device__ __forceinline__ void operator()(AccRef acc, const Unit& u, int wr, int wc, int fr, int fq) const {
        const int c0 = u.pn * 128 + 32 * wc + 8 * fq;
        const f32x4 b10 = *(const f32x4*)(bg + c0), b11 = *(const f32x4*)(bg + c0 + 4), b20 = *(const f32x4*)(bg + 1024 + c0), b21 = *(const f32x4*)(bg + 1024 + c0 + 4);
#pragma unroll
        for (int ai = 0; ai < 2; ++ai)
#pragma unroll
            for (int m = 0; m < 4; ++m) { const size_t off = (size_t)(u.pm * 256 + ai * HALF + wr * 64 + m * 16 + fr) * DM + c0;
                f32x4 ta, tb, sa, sb; unpack8(*(const u32x4*)(T1 + off), ta, tb); unpack8(*(const u32x4*)(SGS + off), sa, sb);
                f32x4 z1a = acc[ai][0][m][0] + b10, z1b = acc[ai][0][m][1] + b11, z2a = acc[ai][1][m][0] + b20, z2b = acc[ai][1][m][1] + b21;
#pragma unroll
                for (int i = 0; i < 4; ++i) { ta[i] += sa[i] * z1a[i] * sigm(z2a[i]); tb[i] += sb[i] * z1b[i] * sigm(z2b[i]); }
                *(u32x4*)(MIX + off) = pack8(ta, tb); asm volatile("" ::: "memory"); }
    }
};
struct EpiX2 {
    static constexpr bool PERM = false;
    const float* X; float* X2;
    __device__ __forceinline__ void operator()(AccRef acc, const Unit& u, int wr, int wc, int fr, int fq) const {
#pragma unroll
        for (int ai = 0; ai < 2; ++ai)
#pragma unroll
            for (int m = 0; m < 4; ++m) { const size_t off = (size_t)(u.pm * 256 + ai * HALF + wr * 64 + m * 16 + fr) * DM + u.pn * 256 + 32 * wc + 4 * fq;
#pragma unroll
                for (int bj = 0; bj < 2; ++bj)
#pragma unroll
                    for (int n = 0; n < 2; ++n) *(f32x4*)(X2 + off + 128 * bj + 16 * n) = *(const f32x4*)(X + off + 128 * bj + 16 * n) + acc[ai][bj][m][n]; asm volatile("" ::: "memory"); }
    }
};
struct EpiUp {
    static constexpr bool PERM = true;
    const float* bup; bf16* ACT;
    __device__ __forceinline__ void operator()(AccRef acc, const Unit& u, int wr, int wc, int fr, int fq) const {
        const int c0 = u.pn * 128 + 32 * wc + 8 * fq; const float* bg = bup + (size_t)u.e * 2048;
        const f32x4 b10 = *(const f32x4*)(bg + c0), b11 = *(const f32x4*)(bg + c0 + 4), b20 = *(const f32x4*)(bg + 1024 + c0), b21 = *(const f32x4*)(bg + 1024 + c0 + 4);
#pragma unroll
        for (int ai = 0; ai < 2; ++ai)
#pragma unroll
            for (int m = 0; m < 4; ++m) { const size_t off = (size_t)(u.pm * 256 + ai * HALF + wr * 64 + m * 16 + fr) * DM + c0;
                f32x4 ga = acc[ai][0][m][0] + b10, gb = acc[ai][0][m][1] + b11, ua = acc[ai][1][m][0] + b20, ub = acc[ai][1][m][1] + b21;
#pragma unroll
                for (int i = 0; i < 4; ++i) { const float g0 = fminf(ga[i], 7.f), g1 = fminf(gb[i], 7.f), u0 = fminf(fmaxf(ua[i], -7.f), 7.f), u1 = fminf(fmaxf(ub[i], -7.f), 7.f);
                    ga[i] = (u0 + 1.f) * g0 * sigm(1.702f * g0); gb[i] = (u1 + 1.f) * g1 * sigm(1.702f * g1); }
                *(u32x4*)(ACT + off) = pack8(ga, gb); asm volatile("" ::: "memory"); }
    }
};
struct EpiDown {
    static constexpr bool PERM = true;
    const float* bdn; const int* list; bf16* YS;
    __device__ __forceinline__ void operator()(AccRef acc, const Unit& u, int wr, int wc, int fr, int fq) const {
        const int c0 = u.pn * 256 + 32 * wc + 8 * fq; const float* bb = bdn + (size_t)u.e * 1024;
        f32x4 bv[2][2];
#pragma unroll
        for (int bj = 0; bj < 2; ++bj)
#pragma unroll
            for (int n = 0; n < 2; ++n) bv[bj][n] = *(const f32x4*)(bb + c0 + 128 * bj + 4 * n);
#pragma unroll
        for (int ai = 0; ai < 2; ++ai)
#pragma unroll
            for (int m = 0; m < 4; ++m) { const int rl = ai * HALF + wr * 64 + m * 16 + fr;
                if (rl < u.nv) { const int pair = list[u.lb + rl];
#pragma unroll
                    for (int bj = 0; bj < 2; ++bj) *(u32x4*)(YS + (size_t)pair * DM + c0 + 128 * bj) = pack8(acc[ai][bj][m][0] + bv[bj][0], acc[ai][bj][m][1] + bv[bj][1]); } asm volatile("" ::: "memory"); }
    }
};
struct EpiFinal {
    static constexpr bool PERM = false;
    float* OUT; const bf16* PP; const float* PSS; const float* gpost;
    __device__ __forceinline__ void operator()(AccRef acc, const Unit& u, int wr, int wc, int fr, int fq) const {
        const int cb = u.pn * 256 + 32 * wc + 4 * fq;
        f32x4 gp[2][2];
#pragma unroll
        for (int bj = 0; bj < 2; ++bj)
#pragma unroll
            for (int n = 0; n < 2; ++n) gp[bj][n] = *(const f32x4*)(gpost + cb + 128 * bj + 16 * n);
#pragma unroll
        for (int ai = 0; ai < 2; ++ai)
#pragma unroll
            for (int m = 0; m < 4; ++m) { const int row = u.pm * 256 + ai * HALF + wr * 64 + m * 16 + fr; const size_t off = (size_t)row * DM + cb;
                const f32x4* ps = (const f32x4*)(PSS + (size_t)row * 16); const f32x4 p0 = ps[0], p1 = ps[1], p2 = ps[2], p3 = ps[3];
                const float tot = ((p0[0] + p0[1]) + (p0[2] + p0[3])) + ((p1[0] + p1[1]) + (p1[2] + p1[3])) + ((p2[0] + p2[1]) + (p2[2] + p2[3])) + ((p3[0] + p3[1]) + (p3[2] + p3[3]));
                const float rp = rsqrtf(tot * (1.f / DM) + EPS);
#pragma unroll
                for (int bj = 0; bj < 2; ++bj)
#pragma unroll
                    for (int n = 0; n < 2; ++n) { const u32x2 pw = *(const u32x2*)(PP + off + 128 * bj + 16 * n); const f32x4 pv = (f32x4){bflo(pw.x), bfhi(pw.x), bflo(pw.y), bfhi(pw.y)};
                        f32x4 o = *(const f32x4*)(OUT + off + 128 * bj + 16 * n); const f32x4 a = acc[ai][bj][m][n];
#pragma unroll
                        for (int i = 0; i < 4; ++i) o[i] += sigm(a[i]) * (pv[i] * rp * gp[bj][n][i]);
                        *(f32x4*)(OUT + off + 128 * bj + 16 * n) = o; } asm volatile("" ::: "memory"); }
    }
};
}
struct Frame {
    LAS unsigned char* lds; gu32* ctl; int tid, lane, wave, G, bx;
    unsigned char* ws; float* out;
};
constexpr int PTAB_OFF = LDSCTL_OFF + 1024;
__device__ __forceinline__ const float* fin_load(const Frame& F, int i) {
    const unsigned long long v = ((const LAS unsigned long long*)(F.lds + PTAB_OFF))[i];
    const unsigned lo = __builtin_amdgcn_readfirstlane((unsigned)v), hi = __builtin_amdgcn_readfirstlane((unsigned)(v >> 32));
    return (const float*)(((unsigned long long)hi << 32) | lo);
}
#define FIN(i) (fin_load(F, (i)))
template <class T> __device__ __forceinline__ T* wsp(const Frame& F, size_t off) { return (T*)(F.ws + off); }

__device__ __forceinline__ void p0_transpose_item(const float* W, int K, int N, bf16* WT, int prow, LAS float* scr, int kb, int nb, int lane) {
    const int k0 = 64 * kb, n0 = 32 * nb;
#pragma unroll 8
    for (int i = 0; i < 32; ++i) { const int kk = 2 * i + (lane >> 5); scr[kk * 33 + (lane & 31)] = W[(size_t)(k0 + kk) * N + n0 + (lane & 31)]; }
    LDS_WAIT(); asm volatile("" ::: "memory");
    const int c = lane & 7;
#pragma unroll
    for (int j = 0; j < 4; ++j) { const int n = (lane >> 3) + 8 * j; const LAS float* s = scr + (8 * c) * 33 + n;
        u32x4 o; o.x = pk2(s[0 * 33], s[1 * 33]); o.y = pk2(s[2 * 33], s[3 * 33]); o.z = pk2(s[4 * 33], s[5 * 33]); o.w = pk2(s[6 * 33], s[7 * 33]);
        *(GAS u32x4*)(WT + (size_t)(prow + n) * K + k0 + 8 * c) = o; }
    LDS_WAIT(); asm volatile("" ::: "memory");
}
__device__ __forceinline__ int prow0(int kind, int n0) {
    if (kind == 1) { if (n0 < 1024) { const int pn = n0 >> 8, wcb = (n0 >> 6) & 3, bjb = (n0 >> 5) & 1; return 256 * pn + 128 * bjb + 32 * wcb; } return n0; }
    if (kind == 2) { const int bj = n0 >> 10, rem = n0 & 1023; return 256 * (rem >> 7) + 128 * bj + (rem & 127); }
    return n0;
}
__device__ __forceinline__ void abar_pow(float lr, float li, float dt, int n, float& er, float& ei) {
    const double rev = (double)li * (double)dt * (double)n * 0.15915494309189535;
    const float f = (float)(rev - __builtin_rint(rev));
    const float mag = expf(lr * dt * (float)n);
    er = mag * __builtin_amdgcn_cosf(f); ei = mag * __builtin_amdgcn_sinf(f);
}
__device__ __forceinline__ void zoh_f(float lr, float li, float dt, float& fr, float& fi) {
    float ar, ai; abar_pow(lr, li, dt, 1, ar, ai);
    const float den = lr * lr + li * li, nr = ar - 1.f; fr = (nr * lr + ai * li) / den; fi = (ai * lr - nr * li) / den;
}
constexpr int IT_WIN = 16 * 128, IT_WAB = 8 * 32, IT_WGLU = 8 * 64, IT_WOUT = 16 * 32, IT_WPG = 16 * 32, IT_WPP = 4 * 32, IT_WUP1 = 16 * 64, IT_WDN1 = 16 * 32;
constexpr int IT_T0 = 0, IT_T1 = IT_T0 + IT_WIN, IT_T2 = IT_T1 + IT_WAB, IT_T3 = IT_T2 + IT_WGLU, IT_T4 = IT_T3 + IT_WOUT, IT_T5 = IT_T4 + IT_WPG, IT_T6 = IT_T5 + IT_WPP, IT_T7 = IT_T6 + 32 * IT_WUP1,
              IT_T8 = IT_T7 + 32 * IT_WDN1;
constexpr int IT_XN = IT_T8, IT_PBF = IT_XN + NTOK, IT_PT = IT_PBF + 4096, IT_RT = IT_PT + 2048, IT_MT = IT_RT + 2048, IT_A64 = IT_MT + 32 * 65, IT_END = IT_A64 + 32;
__device__ __forceinline__ void p0_prologue(Frame& F) {
    LAS float* scr = (LAS float*)(F.lds + F.wave * 16384);
    const int lane = F.lane, gw = F.bx * NWAVES + F.wave, NGW = F.G * NWAVES;
    for (int it = gw; it < IT_END; it += NGW) {
        if (it < IT_T8) {
            const float* W; bf16* WT; int K, N, kind, r;
            if (it < IT_T1) { r = it - IT_T0; W = FIN(3); K = 1024; N = 4096; kind = 1; WT = wsp<bf16>(F, WS_WIN); }
            else if (it < IT_T2) { r = it - IT_T1; W = FIN(6); K = 512; N = 1024; kind = 0; WT = wsp<bf16>(F, WS_WAB); }
            else if (it < IT_T3) { r = it - IT_T2; W = FIN(15); K = 512; N = 2048; kind = 2; WT = wsp<bf16>(F, WS_WGLU); }
            else if (it < IT_T4) { r = it - IT_T3; W = FIN(17); K = 1024; N = 1024; kind = 0; WT = wsp<bf16>(F, WS_WOUT); }
            else if (it < IT_T5) { r = it - IT_T4; W = FIN(26); K = 1024; N = 1024; kind = 0; WT = wsp<bf16>(F, WS_WPG); }
            else if (it < IT_T6) { r = it - IT_T5; W = FIN(27); K = 256; N = 1024; kind = 0; WT = wsp<bf16>(F, WS_WPP); }
            else if (it < IT_T7) { r = it - IT_T6; const int e = r / IT_WUP1; r -= e * IT_WUP1; W = FIN(21) + (size_t)e * 1024 * 2048; K = 1024; N = 2048; kind = 2; WT = wsp<bf16>(F, WS_WUP) + (size_t)e * 2048 * 1024; }
            else { r = it - IT_T7; const int e = r / IT_WDN1; r -= e * IT_WDN1; W = FIN(23) + (size_t)e * 1024 * 1024; K = 1024; N = 1024; kind = 0; WT = wsp<bf16>(F, WS_WDN) + (size_t)e * 1024 * 1024; }
            const int nblk = N / 32, kb = r / nblk, nb = r % nblk;
            p0_transpose_item(W, K, N, WT, prow0(kind, 32 * nb), scr, kb, nb, lane);
        } else if (it < IT_PBF) {
            const int row = it - IT_XN; const GAS f32x4* xr = (const GAS f32x4*)(FIN(0) + (size_t)row * DM) + lane; const GAS f32x4* gr = (const GAS f32x4*)FIN(2) + lane;
            f32x4 v[4]; float s = 0.f;
#pragma unroll
            for (int j = 0; j < 4; ++j) { v[j] = xr[64 * j]; s += (v[j].x * v[j].x + v[j].y * v[j].y) + (v[j].z * v[j].z + v[j].w * v[j].w); }
            const float r = rsqrtf(wave_sum(s) * (1.f / DM) + EPS);
            GAS u32x2* o8 = (GAS u32x2*)(wsp<bf16>(F, WS_XN) + (size_t)row * DM) + lane;
#pragma unroll
            for (int j = 0; j < 4; ++j) { const f32x4 g = gr[64 * j]; u32x2 w; w.x = pk2(v[j].x * r * g.x, v[j].y * r * g.y); w.y = pk2(v[j].z * r * g.z, v[j].w * r * g.w); o8[64 * j] = w; }
        } else if (it < IT_PT) {
            const int q = it - IT_PBF; const GAS f32x4* pr = (const GAS f32x4*)(FIN(1) + (size_t)q * 1024) + lane; GAS u32x2* o8 = (GAS u32x2*)(wsp<bf16>(F, WS_PBF) + (size_t)q * 1024) + lane;
#pragma unroll
            for (int j = 0; j < 4; ++j) { const f32x4 v = pr[64 * j]; u32x2 w; w.x = pk2(v.x, v.y); w.y = pk2(v.z, v.w); o8[64 * j] = w; }
        } else {
            int r, kindt; if (it < IT_RT) { r = it - IT_PT; kindt = 0; } else if (it < IT_MT) { r = it - IT_RT; kindt = 1; } else if (it < IT_A64) { r = it - IT_MT; kindt = 2; } else { r = it - IT_A64; kindt = 3; }
            const int g = (kindt == 2) ? r / 65 : (kindt == 3 ? r : r >> 6), sub = (kindt == 2) ? r % 65 : (r & 63), p = lane;
            const float lr = FIN(7)[g * 64 + p], li = FIN(8)[g * 64 + p], dt = expf(FIN(9)[g]);
            if (kindt == 3) { float er, ei; abar_pow(lr, li, dt, 64, er, ei); float* a = wsp<float>(F, WS_A64) + (g * 64 + p) * 2; a[0] = er; a[1] = ei; continue; }
            float fr, fi; zoh_f(lr, li, dt, fr, fi);
            if (kindt == 0) {
                const int j = sub; float er, ei; abar_pow(lr, li, dt, 63 - j, er, ei);
                float re[16], im[16];
#pragma unroll
                for (int c = 0; c < 16; ++c) { const float br = FIN(10)[(g * 64 + p) * 16 + c], bi = FIN(11)[(g * 64 + p) * 16 + c]; const float bbr = fr * br - fi * bi, bbi = fr * bi + fi * br;
                    re[c] = er * bbr - ei * bbi; im[c] = er * bbi + ei * bbr; }
                bf16* P = wsp<bf16>(F, WS_PTAB) + (size_t)g * 128 * 1024;
                u32x4 w0, w1; w0.x = pk2(re[0], re[1]); w0.y = pk2(re[2], re[3]); w0.z = pk2(re[4], re[5]); w0.w = pk2(re[6], re[7]); w1.x = pk2(re[8], re[9]); w1.y = pk2(re[10], re[11]); w1.z = pk2(re[12], re[13]); w1.w = pk2(re[14], re[15]);
                *(u32x4*)(P + (size_t)p * 1024 + j * 16) = w0; *(u32x4*)(P + (size_t)p * 1024 + j * 16 + 8) = w1;
                w0.x = pk2(im[0], im[1]); w0.y = pk2(im[2], im[3]); w0.z = pk2(im[4], im[5]); w0.w = pk2(im[6], im[7]); w1.x = pk2(im[8], im[9]); w1.y = pk2(im[10], im[11]); w1.z = pk2(im[12], im[13]); w1.w = pk2(im[14], im[15]);
                *(u32x4*)(P + (size_t)(64 + p) * 1024 + j * 16) = w0; *(u32x4*)(P + (size_t)(64 + p) * 1024 + j * 16 + 8) = w1;
            } else if (kindt == 1) {
                const int t = sub; float er, ei; abar_pow(lr, li, dt, t + 1, er, ei);
                bf16* R = wsp<bf16>(F, WS_RTAB) + (size_t)g * 1024 * 128;
#pragma unroll 4
                for (int c = 0; c < 16; ++c) { const float cr = FIN(12)[(g * 16 + c) * 64 + p], ci = FIN(13)[(g * 16 + c) * 64 + p];
                    R[(size_t)(t * 16 + c) * 128 + p] = (bf16)f2bf(cr * er - ci * ei); R[(size_t)(t * 16 + c) * 128 + 64 + p] = (bf16)f2bf(-(cr * ei + ci * er)); }
            } else {
                const int dd = sub; bf16* M = wsp<bf16>(F, WS_MTAB) + ((size_t)g * 65 + dd) * 256;
                if (dd == 0) { for (int k = 0; k < 4; ++k) M[lane + 64 * k] = 0; continue; }
                float er, ei; abar_pow(lr, li, dt, dd - 1, er, ei);
                float X[16], Y[16];
#pragma unroll
                for (int c = 0; c < 16; ++c) { const float br = FIN(10)[(g * 64 + p) * 16 + c], bi = FIN(11)[(g * 64 + p) * 16 + c]; const float bbr = fr * br - fi * bi, bbi = fr * bi + fi * br;
                    X[c] = er * bbr - ei * bbi; Y[c] = er * bbi + ei * bbr; }
                float keep[4] = {0.f, 0.f, 0.f, 0.f};
#pragma unroll
                for (int c = 0; c < 16; ++c) { const float cr = FIN(12)[(g * 16 + c) * 64 + p], ci = FIN(13)[(g * 16 + c) * 64 + p];
#pragma unroll
                    for (int c2 = 0; c2 < 16; ++c2) { const float s = wave_sum(cr * X[c2] - ci * Y[c2]); const int e = c * 16 + c2; if ((e & 63) == lane) keep[e >> 6] = s; } }
#pragma unroll
                for (int k = 0; k < 4; ++k) M[lane + 64 * k] = (bf16)f2bf(keep[k]);
            }
        }
    }
}

__device__ __forceinline__ int crow(int r, int hi) { return (r & 3) + 8 * (r >> 2) + 4 * hi; }
constexpr float LOG2E = 1.4426950408889634f;
constexpr float ATTN_DEAD = -160.f;
template <bool EARLY_EXIT>
__device__ __forceinline__ void attn_tile(const bf16* __restrict__ QH, const bf16* __restrict__ KH, const bf16* __restrict__ VT, bf16* __restrict__ O, int bh, int qt, int lane) {
    const int r32 = lane & 31, hi = lane >> 5;
    const bf16* Qp = QH + ((size_t)bh * SEQ + qt * 32 + r32) * HD + hi * 8;
    bf16x8 qf[4];
#pragma unroll
    for (int ks = 0; ks < 4; ++ks) qf[ks] = *(const bf16x8*)(Qp + ks * 16);
    bf16x8 tri[2];
#pragma unroll
    for (int s = 0; s < 2; ++s)
#pragma unroll
        for (int jj = 0; jj < 8; ++jj) { const int jp = 16 * s + 8 * (jj >> 2) + 4 * hi + (jj & 3); tri[s][jj] = (jp > r32) ? (short)0x3f80 : (short)0; }
    f32x16 oT[2]; oT[0] = f32x16{}; oT[1] = f32x16{};
    float R = 0.f;
    for (int kb = qt; kb >= 0; --kb) {
        const bf16* Kp = KH + ((size_t)bh * SEQ + kb * 32 + r32) * HD + hi * 8;
        f32x16 st = f32x16{};
#pragma unroll
        for (int ks = 0; ks < 4; ++ks) { const bf16x8 kf = *(const bf16x8*)(Kp + ks * 16); st = __builtin_amdgcn_mfma_f32_32x32x16_bf16(kf, qf[ks], st, 0, 0, 0); }
        f32x16 sp, lg;
        const bool diag = (kb == qt);
#pragma unroll
        for (int r = 0; r < 16; ++r) {
            const float z = st[r]; const float e = __builtin_amdgcn_exp2f(-__builtin_fabsf(z)); const float l2 = __builtin_amdgcn_logf(1.f + e);
            float s_ = __builtin_fmaxf(z, 0.f) + l2, g_ = __builtin_fminf(z, 0.f) - l2;
            if (diag && crow(r, hi) >= r32) { s_ = 0.f; g_ = -1e30f; }
            sp[r] = s_; lg[r] = g_;
        }
        f32x16 later;
#pragma unroll
        for (int r = 0; r < 16; ++r) later[r] = R;
        {
            u32x4 w0, w1;
            w0.x = pk2(-sp[0], -sp[1]); w0.y = pk2(-sp[2], -sp[3]); w0.z = pk2(-sp[4], -sp[5]); w0.w = pk2(-sp[6], -sp[7]);
            w1.x = pk2(-sp[8], -sp[9]); w1.y = pk2(-sp[10], -sp[11]); w1.z = pk2(-sp[12], -sp[13]); w1.w = pk2(-sp[14], -sp[15]);
            later = __builtin_amdgcn_mfma_f32_32x32x16_bf16(tri[0], __builtin_bit_cast(bf16x8, w0), later, 0, 0, 0);
            later = __builtin_amdgcn_mfma_f32_32x32x16_bf16(tri[1], __builtin_bit_cast(bf16x8, w1), later, 0, 0, 0);
        }
        u32x4 p0, p1;
        {
            float w[16];
#pragma unroll
            for (int r = 0; r < 16; ++r) w[r] = __builtin_amdgcn_exp2f(lg[r] + later[r]);
            p0.x = pk2(w[0], w[1]); p0.y = pk2(w[2], w[3]); p0.z = pk2(w[4], w[5]); p0.w = pk2(w[6], w[7]);
            p1.x = pk2(w[8], w[9]); p1.y = pk2(w[10], w[11]); p1.z = pk2(w[12], w[13]); p1.w = pk2(w[14], w[15]);
        }
#pragma unroll
        for (int mt = 0; mt < 2; ++mt) {
            const bf16* Vp = VT + ((size_t)bh * HD + 32 * mt + r32) * SEQ + kb * 32 + 4 * hi;
            const u32x2 a0 = *(const u32x2*)(Vp), a1 = *(const u32x2*)(Vp + 8), a2 = *(const u32x2*)(Vp + 16), a3 = *(const u32x2*)(Vp + 24);
            const u32x4 v0 = (u32x4){a0.x, a0.y, a1.x, a1.y}, v1 = (u32x4){a2.x, a2.y, a3.x, a3.y};
            oT[mt] = __builtin_amdgcn_mfma_f32_32x32x16_bf16(__builtin_bit_cast(bf16x8, v0), __builtin_bit_cast(bf16x8, p0), oT[mt], 0, 0, 0);
            oT[mt] = __builtin_amdgcn_mfma_f32_32x32x16_bf16(__builtin_bit_cast(bf16x8, v1), __builtin_bit_cast(bf16x8, p1), oT[mt], 0, 0, 0);
        }
        R = __shfl(later[0] - sp[0], r32);
        if (EARLY_EXIT) { if (__all(R < ATTN_DEAD)) break; }
    }
    bf16* Op = O + ((size_t)(bh >> 3) * SEQ + qt * 32 + r32) * 512 + (bh & 7) * HD + 4 * hi;
#pragma unroll
    for (int mt = 0; mt < 2; ++mt)
#pragma unroll
        for (int q = 0; q < 4; ++q) { u32x2 w; w.x = pk2(oT[mt][4 * q], oT[mt][4 * q + 1]); w.y = pk2(oT[mt][4 * q + 2], oT[mt][4 * q + 3]); *(u32x2*)(Op + 32 * mt + 8 * q) = w; }
}
constexpr int SSM_U = 0, SSM_MT = 65536, SSM_SLOC = SSM_MT + 33280, SSM_SPREV = SSM_SLOC + 16384, SSM_END = SSM_SPREV + 8192;
static_assert(SSM_END <= RING_BYTES, "ssm lds");
__device__ __forceinline__ void ssm_item(Frame& F, int b, int g) {
    LAS unsigned char* lds = F.lds; const int tid = F.tid, lane = F.lane, w = F.wave;
    const bf16* U = wsp<bf16>(F, WS_U);
#pragma unroll
    for (int i = 0; i < 8; ++i) { const int q = tid + 512 * i, row = q >> 1, half = q & 1, n = row >> 6, j = row & 63;
        *(LAS u32x4*)(lds + SSM_U + ((j * 32 + n) * 16 + half * 8) * 2) = *(const u32x4*)(U + ((size_t)(b * SEQ + row)) * 512 + g * 16 + half * 8); }
    { const u32x4* src = (const u32x4*)(wsp<bf16>(F, WS_MTAB) + (size_t)g * 65 * 256);
      for (int q = tid; q < 2080; q += 512) *(LAS u32x4*)(lds + SSM_MT + q * 16) = src[q]; }
    __syncthreads();
    const int fr = lane & 15, fq = lane >> 4;
    {
        f32x4 a0 = (f32x4){0.f, 0.f, 0.f, 0.f}, a1 = a0;
        const bf16* Pg = wsp<bf16>(F, WS_PTAB) + (size_t)g * 128 * 1024 + (size_t)(16 * w + fr) * 1024 + 8 * fq;
#pragma unroll 4
        for (int j0 = 0; j0 < 32; ++j0) {
            const bf16x8 af = *(const bf16x8*)(Pg + 32 * j0);
            const int ub = SSM_U + (((2 * j0 + (lane >> 5)) * 32 + fr) * 16 + 8 * (fq & 1)) * 2;
            const bf16x8 b0 = *(const LAS bf16x8*)(lds + ub), b1 = *(const LAS bf16x8*)(lds + ub + 16 * 32);
            a0 = __builtin_amdgcn_mfma_f32_16x16x32_bf16(af, b0, a0, 0, 0, 0); a1 = __builtin_amdgcn_mfma_f32_16x16x32_bf16(af, b1, a1, 0, 0, 0);
        }
        LAS float* SL = (LAS float*)(lds + SSM_SLOC);
#pragma unroll
        for (int r = 0; r < 4; ++r) { SL[(16 * w + 4 * fq + r) * 32 + fr] = a0[r]; SL[(16 * w + 4 * fq + r) * 32 + 16 + fr] = a1[r]; }
    }
    __syncthreads();
    if (tid < 64) {
        const int p = tid; const float* a = wsp<float>(F, WS_A64) + (g * 64 + p) * 2; const float ar = a[0], ai = a[1];
        const LAS float* SL = (const LAS float*)(lds + SSM_SLOC); LAS bf16* SP = (LAS bf16*)(lds + SSM_SPREV);
        float sr = 0.f, si = 0.f;
#pragma unroll 4
        for (int n = 0; n < 32; ++n) { SP[n * 128 + p] = (bf16)f2bf(sr); SP[n * 128 + 64 + p] = (bf16)f2bf(si);
            const float lr_ = SL[p * 32 + n], li_ = SL[(64 + p) * 32 + n]; const float nr = ar * sr - ai * si + lr_, ni = ar * si + ai * sr + li_; sr = nr; si = ni; }
    }
    __syncthreads();
    f32x4 acc[8][2];
#pragma unroll
    for (int i = 0; i < 8; ++i) { acc[i][0] = (f32x4){0.f, 0.f, 0.f, 0.f}; acc[i][1] = acc[i][0]; }
#pragma unroll 1
    for (int j0 = 0; j0 < 32; ++j0) {
        const int ub = SSM_U + (((2 * j0 + (lane >> 5)) * 32 + fr) * 16 + 8 * (fq & 1)) * 2;
        const bf16x8 b0 = *(const LAS bf16x8*)(lds + ub), b1 = *(const LAS bf16x8*)(lds + ub + 16 * 32);
#pragma unroll
        for (int i = 0; i < 8; ++i) { const int t = w + 8 * i;
            if (2 * j0 <= t) { const int dd = t - 2 * j0 - (lane >> 5) + 1;
                const bf16x8 af = *(const LAS bf16x8*)(lds + SSM_MT + (dd * 256 + fr * 16 + 8 * (fq & 1)) * 2);
                acc[i][0] = __builtin_amdgcn_mfma_f32_16x16x32_bf16(af, b0, acc[i][0], 0, 0, 0); acc[i][1] = __builtin_amdgcn_mfma_f32_16x16x32_bf16(af, b1, acc[i][1], 0, 0, 0); } }
    }
    {
        const bf16* Rg = wsp<bf16>(F, WS_RTAB) + (size_t)g * 1024 * 128;
#pragma unroll
        for (int ks = 0; ks < 4; ++ks) {
            const int sb = SSM_SPREV + (fr * 128 + 32 * ks + 8 * fq) * 2;
            const bf16x8 b0 = *(const LAS bf16x8*)(lds + sb), b1 = *(const LAS bf16x8*)(lds + sb + 16 * 128 * 2);
#pragma unroll
            for (int i = 0; i < 8; ++i) { const int t = w + 8 * i; const bf16x8 af = *(const bf16x8*)(Rg + (size_t)(t * 16 + fr) * 128 + 32 * ks + 8 * fq);
                acc[i][0] = __builtin_amdgcn_mfma_f32_16x16x32_bf16(af, b0, acc[i][0], 0, 0, 0); acc[i][1] = __builtin_amdgcn_mfma_f32_16x16x32_bf16(af, b1, acc[i][1], 0, 0, 0); }
        }
    }
    {
        const f32x4 dsk = *(const f32x4*)(FIN(14) + g * 16 + 4 * fq); bf16* YG = wsp<bf16>(F, WS_YG);
#pragma unroll
        for (int i = 0; i < 8; ++i) { const int t = w + 8 * i;
#pragma unroll
            for (int ng = 0; ng < 2; ++ng) { const int n = 16 * ng + fr; const u32x2 uw = *(const LAS u32x2*)(lds + SSM_U + ((t * 32 + n) * 16 + 4 * fq) * 2);
                const f32x4 uv = (f32x4){bflo(uw.x), bfhi(uw.x), bflo(uw.y), bfhi(uw.y)}; f32x4 y = acc[i][ng] + dsk * uv;
#pragma unroll
                for (int r = 0; r < 4; ++r) { const float v = y[r]; y[r] = v * sigm(1.5957691216057308f * (v + 0.044715f * v * v * v)); }
                u32x2 o; o.x = pk2(y[0], y[1]); o.y = pk2(y[2], y[3]);
                *(u32x2*)(YG + ((size_t)(b * SEQ + n * 64 + t)) * 512 + g * 16 + 4 * fq) = o; } }
    }
    __syncthreads();
}

constexpr int RT_SEL = LDSCTL_OFF + 8192;
__device__ __forceinline__ void router_phase(Frame& F) {
    LAS unsigned char* lds = F.lds; const int tid = F.tid, lane = F.lane, w = F.wave;
    for (int q = tid; q < 8192; q += 512) { const int k = q >> 3, c = q & 7; *(LAS f32x4*)(lds + k * 128 + ((c ^ ((k >> 1) & 7)) << 4)) = *(const f32x4*)(FIN(19) + (size_t)k * 32 + c * 4); }
    LAS int* hist = (LAS int*)(lds + RT_SEL + 2048); LAS int* base = hist + 32; LAS int* rec = (LAS int*)(lds + RT_SEL);
    if (tid < 32) hist[tid] = 0;
    __syncthreads();
    const float* X2 = wsp<float>(F, WS_X2); bf16* H2 = wsp<bf16>(F, WS_XN);
    for (int tb = F.bx; tb < NTOK / 64; tb += F.G) {
#pragma unroll 1
        for (int tt = 0; tt < 8; ++tt) {
            const int tl = w * 8 + tt, tok = tb * 64 + tl;
            const float* xrow = X2 + (size_t)tok * DM + lane; const float* gff = FIN(18) + lane;
            float s = 0.f;
#pragma unroll
            for (int j = 0; j < 16; ++j) { const float x = xrow[64 * j]; s += x * x; }
            const float r = rsqrtf(wave_sum(s) * (1.f / DM) + EPS);
            float acc[32];
#pragma unroll
            for (int e = 0; e < 32; ++e) acc[e] = 0.f;
#pragma unroll 2
            for (int j = 0; j < 16; ++j) { const int k = lane + 64 * j; const float hj = xrow[64 * j] * r * gff[64 * j];
                H2[(size_t)tok * DM + k] = (bf16)f2bf(hj);
#pragma unroll
                for (int c = 0; c < 8; ++c) { const f32x4 wv = *(const LAS f32x4*)(lds + k * 128 + ((c ^ ((k >> 1) & 7)) << 4));
                    acc[4 * c] += hj * wv[0]; acc[4 * c + 1] += hj * wv[1]; acc[4 * c + 2] += hj * wv[2]; acc[4 * c + 3] += hj * wv[3]; } }
#pragma unroll
            for (int st = 0; st < 5; ++st) { const int half = 16 >> st, bit = 32 >> st; const bool up = (lane & bit) != 0;
#pragma unroll
                for (int i = 0; i < 16; ++i) if (i < half) { const float mine = up ? acc[i + half] : acc[i], other = up ? acc[i] : acc[i + half]; acc[i] = mine + __shfl_xor(other, bit); } }
            float logit = acc[0] + __shfl_xor(acc[0], 1);
            const int e_me = (lane >> 1) & 31;
            logit += FIN(20)[e_me];
            float v = logit; float sv[4]; int my_e = 0; float my_v = 0.f;
#pragma unroll
            for (int q = 0; q < 4; ++q) { float bv = v; int bi = e_me;
#pragma unroll
                for (int o = 2; o < 64; o <<= 1) { const float ov = __shfl_xor(bv, o); const int oi = __shfl_xor(bi, o); if (ov > bv || (ov == bv && oi < bi)) { bv = ov; bi = oi; } }
                sv[q] = bv; if (lane == q) { my_e = bi; my_v = bv; } if (e_me == bi) v = -INFINITY; }
            float den = 0.f;
#pragma unroll
            for (int q = 0; q < 4; ++q) den += __expf(sv[q] - sv[0]);
            if (lane < 4) { const int e = my_e; const float wgt = __expf(my_v - sv[0]);
                const int rank = __hip_atomic_fetch_add(hist + e, 1, __ATOMIC_RELAXED, __HIP_MEMORY_SCOPE_WORKGROUP);
                rec[tl * 4 + lane] = (e << 16) | rank; wsp<float>(F, WS_TOPW)[tok * 4 + lane] = wgt / den; }
        }
        __syncthreads();
        if (tid < 32) { base[tid] = (int)atomicAdd((unsigned*)(F.ctl + CW_CNT + tid), (unsigned)hist[tid]); }
        __syncthreads();
        if (tid < 256) { const int rc = rec[tid], e = rc >> 16, rank = rc & 0xffff; wsp<int>(F, WS_LIST)[e * CAP + base[e] + rank] = (tb * 64 + (tid >> 2)) * 4 + (tid & 3); }
        __syncthreads();
        if (tid < 32) hist[tid] = 0;
        __syncthreads();
    }
}

__device__ __forceinline__ void combine_phase(Frame& F) {
    const int lane = F.lane, gw = F.bx * NWAVES + F.wave, NGW = F.G * NWAVES;
    const float* X2 = wsp<float>(F, WS_X2); const bf16* YS = wsp<bf16>(F, WS_YS); const float* TW = wsp<float>(F, WS_TOPW); bf16* H3 = wsp<bf16>(F, WS_XN);
    for (int tok = gw; tok < NTOK; tok += NGW) {
        const f32x4 tw = *(const f32x4*)(TW + tok * 4);
        f32x4 v[4]; float s = 0.f;
#pragma unroll
        for (int j = 0; j < 4; ++j) { v[j] = *((const f32x4*)(X2 + (size_t)tok * DM) + lane + 64 * j);
#pragma unroll
            for (int k = 0; k < 4; ++k) { const u32x2 yw = *((const u32x2*)(YS + ((size_t)tok * 4 + k) * DM) + lane + 64 * j); const float wk = tw[k];
                v[j].x += wk * bflo(yw.x); v[j].y += wk * bfhi(yw.x); v[j].z += wk * bflo(yw.y); v[j].w += wk * bfhi(yw.y); }
            s += (v[j].x * v[j].x + v[j].y * v[j].y) + (v[j].z * v[j].z + v[j].w * v[j].w);
            *((f32x4*)(F.out + (size_t)tok * DM) + lane + 64 * j) = v[j]; }
        const float r = rsqrtf(wave_sum(s) * (1.f / DM) + EPS);
#pragma unroll
        for (int j = 0; j < 4; ++j) { const f32x4 g = *((const f32x4*)FIN(25) + lane + 64 * j); u32x2 o; o.x = pk2(v[j].x * r * g.x, v[j].y * r * g.y); o.y = pk2(v[j].z * r * g.z, v[j].w * r * g.w);
            *((u32x2*)(H3 + (size_t)tok * DM) + lane + 64 * j) = o; }
    }
}
constexpr int NPHASE = 11;
constexpr int MOE_TST = LDSCTL_OFF + 4096;
struct Args { const float* in[29]; float* out; unsigned char* ws; int ph_lo, ph_hi; };
__global__ void __launch_bounds__(NWAVES * 64, 2) mega_fwd(Args args) {
    extern __shared__ __attribute__((aligned(16))) unsigned char lds_raw[];
    Frame F;
    F.lds = (LAS unsigned char*)lds_raw; F.tid = threadIdx.x; F.lane = F.tid & 63; F.wave = __builtin_amdgcn_readfirstlane(F.tid >> 6); F.G = gridDim.x; F.bx = blockIdx.x;
    F.ws = args.ws; F.out = args.out; F.ctl = (gu32*)(args.ws + WS_CTL);
    for (int u = F.tid; u < (LDS_BYTES - LDSCTL_OFF) / 4; u += NWAVES * 64) ((LAS unsigned*)(F.lds + LDSCTL_OFF))[u] = 0u;
    __syncthreads();
    if (F.tid < 29) ((LAS unsigned long long*)(F.lds + PTAB_OFF))[F.tid] = ((const unsigned long long*)__builtin_amdgcn_kernarg_segment_ptr())[F.tid];
    __syncthreads();
    volatile LAS unsigned* MISC = (volatile LAS unsigned*)(F.lds + MISC_OFF);
    XcdBarrier bar = xcd_barrier_post((unsigned*)(F.ctl + CW_BAR), MISC + 8);
    const int lo = args.ph_lo, hi = args.ph_hi;
#ifndef PH_MASK
#define PH_MASK 0xffff
#endif
#define IN_(k) (((PH_MASK >> (k)) & 1) && lo <= (k) && (k) < hi)
#define SEAM(k) do { if (IN_(k) && IN_((k) + 1)) xcd_barrier(bar); } while (0)
    LAS int* tst = (LAS int*)(F.lds + MOE_TST); LAS int* ecnt = tst + 33;

    if (IN_(0)) { p0_prologue(F); } SEAM(0);
    if (IN_(1)) {
        { pg8::Gemm g{wsp<bf16>(F, WS_XN), wsp<bf16>(F, WS_WIN), 1024}; pg8::StaticOrder S; S.init(NTOK, INC, F.G, F.bx);
          epi::EpiInProj E{wsp<bf16>(F, WS_QH), wsp<bf16>(F, WS_KH), wsp<bf16>(F, WS_VT), wsp<bf16>(F, WS_U), wsp<bf16>(F, WS_SGA), wsp<bf16>(F, WS_SGS), FIN(4), FIN(5)};
          pg8::gemm_phase<epi::EpiInProj, pg8::StaticOrder, false>(F.lds, g, S, E); }
        { pg8::Gemm g{wsp<bf16>(F, WS_PBF), wsp<bf16>(F, WS_WPP), 256}; pg8::StaticOrder S; S.init(NTOK, DM, F.G, F.bx);
          epi::EpiPle E{wsp<bf16>(F, WS_PP), wsp<float>(F, WS_PSS)};
          pg8::gemm_phase<epi::EpiPle, pg8::StaticOrder, false>(F.lds, g, S, E); }
    } SEAM(1);
    if (IN_(2)) {
        for (int it = F.bx; it < NBATCH * 32; it += F.G) ssm_item(F, it >> 5, it & 31);
        const int gw = F.bx * NWAVES + F.wave, NGW = F.G * NWAVES;
        for (int it = gw; it < 64 * 32; it += NGW) { const int bh = it >> 5, q = it & 31;
            attn_tile<false>(wsp<bf16>(F, WS_QH), wsp<bf16>(F, WS_KH), wsp<bf16>(F, WS_VT), wsp<bf16>(F, WS_O), bh, q, F.lane);
            attn_tile<false>(wsp<bf16>(F, WS_QH), wsp<bf16>(F, WS_KH), wsp<bf16>(F, WS_VT), wsp<bf16>(F, WS_O), bh, 63 - q, F.lane); }
    } SEAM(2);
    if (IN_(3)) { pg8::Gemm g{wsp<bf16>(F, WS_O), wsp<bf16>(F, WS_WAB), 512}; pg8::StaticOrder S; S.init(NTOK, DM, F.G, F.bx);
        epi::EpiT1 E{wsp<bf16>(F, WS_SGA), wsp<bf16>(F, WS_T1)}; pg8::gemm_phase<epi::EpiT1, pg8::StaticOrder, false>(F.lds, g, S, E); } SEAM(3);
    if (IN_(4)) { pg8::Gemm g{wsp<bf16>(F, WS_YG), wsp<bf16>(F, WS_WGLU), 512}; pg8::StaticOrder S; S.init(NTOK, 2048, F.G, F.bx);
        epi::EpiGlu E{wsp<bf16>(F, WS_T1), wsp<bf16>(F, WS_SGS), FIN(16), wsp<bf16>(F, WS_MIX)}; pg8::gemm_phase<epi::EpiGlu, pg8::StaticOrder, false>(F.lds, g, S, E); } SEAM(4);
    if (IN_(5)) { pg8::Gemm g{wsp<bf16>(F, WS_MIX), wsp<bf16>(F, WS_WOUT), 1024}; pg8::StaticOrder S; S.init(NTOK, DM, F.G, F.bx);
        epi::EpiX2 E{FIN(0), wsp<float>(F, WS_X2)}; pg8::gemm_phase<epi::EpiX2, pg8::StaticOrder, false>(F.lds, g, S, E); } SEAM(5);
    if (IN_(6)) { router_phase(F); } SEAM(6);
    if (IN_(7) || IN_(8)) {
        if (F.tid == 0) { int a = 0; for (int e = 0; e < NE; ++e) { const int c = (int)__hip_atomic_load(F.ctl + CW_CNT + e, RLX_AGENT); ecnt[e] = c; tst[e] = a; a += (c + 255) >> 8; } tst[32] = a; }
        __syncthreads();
    }
    if (IN_(7)) { pg8::Gemm g{wsp<bf16>(F, WS_XN), wsp<bf16>(F, WS_WUP), 1024}; pg8::MoeOrder S{tst, ecnt, wsp<int>(F, WS_LIST), 8, F.bx, F.G, 2};
        epi::EpiUp E{FIN(22), wsp<bf16>(F, WS_ACT)}; pg8::gemm_phase<epi::EpiUp, pg8::MoeOrder, true>(F.lds, g, S, E); } SEAM(7);
    if (IN_(8)) { pg8::Gemm g{wsp<bf16>(F, WS_ACT), wsp<bf16>(F, WS_WDN), 1024}; pg8::MoeOrder S{tst, ecnt, wsp<int>(F, WS_LIST), 4, F.bx, F.G, 0};
        epi::EpiDown E{FIN(24), wsp<int>(F, WS_LIST), wsp<bf16>(F, WS_YS)}; pg8::gemm_phase<epi::EpiDown, pg8::MoeOrder, false>(F.lds, g, S, E); } SEAM(8);
    if (IN_(9)) { combine_phase(F); } SEAM(9);
    if (IN_(10)) { pg8::Gemm g{wsp<bf16>(F, WS_XN), wsp<bf16>(F, WS_WPG), 1024}; pg8::StaticOrder S; S.init(NTOK, DM, F.G, F.bx);
        epi::EpiFinal E{F.out, wsp<bf16>(F, WS_PP), wsp<float>(F, WS_PSS), FIN(28)}; pg8::gemm_phase<epi::EpiFinal, pg8::StaticOrder, false>(F.lds, g, S, E); }
#undef IN_
#undef SEAM
}

__global__ void g_bf2f(const bf16* src, float* dst, size_t n) { const size_t i = (size_t)blockIdx.x * blockDim.x + threadIdx.x; if (i < n) dst[i] = bflo((unsigned)src[i]); }
__global__ void g_proj(const bf16* QH, const bf16* KH, const bf16* VT, const bf16* U, const bf16* SGA, const bf16* SGS, float* PROJ, int mask) {
    const size_t i = (size_t)blockIdx.x * blockDim.x + threadIdx.x; if (i >= (size_t)NTOK * INC) return;
    const int t = (int)(i >> 12), c = (int)(i & 4095), b = t >> 11, s = t & 2047; float v;
    { const int sec = c < 512 ? 0 : c < 1024 ? 1 : c < 1536 ? 2 : c < 2048 ? 3 : c < 3072 ? 4 : 5; if (!((mask >> sec) & 1)) return; }
    if (c < 512) { const int h = c >> 6, d = c & 63; v = bflo(QH[((size_t)(b * 8 + h) * SEQ + s) * 64 + d]) * (1.f / LOG2E); }
    else if (c < 1024) { const int cc = c - 512, h = cc >> 6, d = cc & 63; v = bflo(KH[((size_t)(b * 8 + h) * SEQ + s) * 64 + d]); }
    else if (c < 1536) { const int cc = c - 1024; v = bflo(VT[((size_t)b * 512 + cc) * SEQ + s]); }
    else if (c < 2048) v = bflo(U[(size_t)t * 512 + c - 1536]);
    else if (c < 3072) v = bflo(SGA[(size_t)t * 1024 + c - 2048]);
    else v = bflo(SGS[(size_t)t * 1024 + c - 3072]);
    PROJ[i] = v;
}
}

#ifndef HYB
#define HYB 0
#endif
extern "C" void kernel_launch(void* const* d_in, const int* in_sizes, int n_in, void* d_out, int out_size, void* d_ws, size_t ws_size, hipStream_t stream) {
    using namespace mk;
    static int grid = 0;
    if (grid == 0) {
        int dev = 0, cus = 0, per_cu = 0;
        if (hipGetDevice(&dev) != hipSuccess || hipDeviceGetAttribute(&cus, hipDeviceAttributeMultiprocessorCount, dev) != hipSuccess) { fprintf(stderr, "kernel_launch: device query failed\n"); grid = -1; return; }
        if (hipFuncSetAttribute((const void*)mega_fwd, hipFuncAttributeMaxDynamicSharedMemorySize, LDS_BYTES) != hipSuccess) { fprintf(stderr, "kernel_launch: hipFuncSetAttribute failed\n"); grid = -1; return; }
        if (hipOccupancyMaxActiveBlocksPerMultiprocessor(&per_cu, (const void*)mega_fwd, NWAVES * 64, LDS_BYTES) != hipSuccess || per_cu < 1) fprintf(stderr, "kernel_launch: occupancy query says %d\n", per_cu);
        (void)hipGetLastError();
        grid = cus;
        if (ws_size < WS_END) { fprintf(stderr, "kernel_launch: workspace too small\n"); grid = -1; return; }
    }
    if (grid < 0) return;
    hipMemsetAsync((char*)d_ws + WS_CTL, 0, CTL_ZERO_BYTES, stream);
    Args a{};
    for (int i = 0; i < 29; ++i) a.in[i] = (const float*)d_in[i];
    a.out = (float*)d_out; a.ws = (unsigned char*)d_ws;
    const int hyb_hi[6] = {NPHASE, 2, 3, 6, 10, NPHASE};
    a.ph_lo = 0; a.ph_hi = hyb_hi[HYB];
    hipLaunchKernelGGL(mega_fwd, dim3(grid), dim3(NWAVES * 64), LDS_BYTES, stream, a);
#if HYB != 0
    {
        unsigned char* ws = (unsigned char*)d_ws; float* nPP = (float*)(ws + 720 * MiB); float* nPROJ = (float*)(ws + 64 * MiB);
#ifndef GLUEMASK
#define GLUEMASK 0x7f
#endif
        int gmask = (HYB == 2) ? 0x30 : (GLUEMASK & 0x3f); const int ppg = (GLUEMASK >> 6) & 1;
        if (ppg) hipLaunchKernelGGL(g_bf2f, dim3(NTOK * DM / 256), dim3(256), 0, stream, (const bf16*)(ws + WS_PP), nPP, (size_t)NTOK * DM);
        if (HYB == 1 && gmask != 0x3f) {
            hipLaunchKernelGGL(nv::k_rmsnorm, dim3(NTOK / 4), dim3(256), 0, stream, (const float*)d_in[0], (const float*)d_in[2], (float*)ws, NTOK);
            nv::gemm(stream, (float*)ws, DM, (const float*)d_in[3], INC, nPROJ, INC, NTOK, INC, DM, nullptr, nullptr);
            hipLaunchKernelGGL(nv::k_qknorm, dim3(NTOK * 16 / 256), dim3(256), 0, stream, nPROJ, (const float*)d_in[4], (const float*)d_in[5]);
        }
        if (HYB == 1 || HYB == 2)
            hipLaunchKernelGGL(g_proj, dim3(NTOK * INC / 256), dim3(256), 0, stream, (const bf16*)(ws + WS_QH), (const bf16*)(ws + WS_KH), (const bf16*)(ws + WS_VT), (const bf16*)(ws + WS_U), (const bf16*)(ws + WS_SGA), (const bf16*)(ws + WS_SGS), nPROJ, gmask);
        if (HYB == 2) {
            hipLaunchKernelGGL(g_bf2f, dim3(NTOK * 512 / 256), dim3(256), 0, stream, (const bf16*)(ws + WS_O), (float*)(ws + 320 * MiB), (size_t)NTOK * 512);
            hipLaunchKernelGGL(g_bf2f, dim3(NTOK * 512 / 256), dim3(256), 0, stream, (const bf16*)(ws + WS_YG), (float*)(ws + 352 * MiB), (size_t)NTOK * 512);
        }
        if (HYB == 3) hipMemcpyAsync(ws + 640 * MiB, ws + WS_X2, (size_t)NTOK * DM * 4, hipMemcpyDeviceToDevice, stream);
        nv::forward(d_in, (float*)d_out, ws, stream, HYB, (HYB == 1 && (gmask & 0x30) != 0x30) ? 0 : 1, ppg, (const float*)(ws + 640 * MiB));
    }
#endif
}
```

```cpp
#define HYB 0
#define GLUEMASK 0x7f
#include <hip/hip_runtime.h>
#include <cstdint>
#include <cstdio>

namespace nv {
constexpr int NTOK = 16384, DM = 1024, SEQ = 2048, NB = 8, INC = 4096, NE = 32, CAP = 16384;
constexpr float EPS = 1e-6f;

__device__ __forceinline__ float sigmoidf_(float x) { return 1.f / (1.f + __expf(-x)); }
__device__ __forceinline__ float wave_sum(float v) {
#pragma unroll
    for (int o = 1; o < 64; o <<= 1) v += __shfl_xor(v, o);
    return v;
}

__global__ void k_rmsnorm(const float* x, const float* g, float* out, int rows) {
    const int lane = threadIdx.x & 63, w = (blockIdx.x * blockDim.x + threadIdx.x) >> 6;
    if (w >= rows) return;
    const float4* xr = (const float4*)(x + (size_t)w * DM);
    float4 v[4]; float s = 0.f;
#pragma unroll
    for (int j = 0; j < 4; ++j) { v[j] = xr[lane + 64 * j]; s += v[j].x * v[j].x + v[j].y * v[j].y + v[j].z * v[j].z + v[j].w * v[j].w; }
    const float r = rsqrtf(wave_sum(s) * (1.f / DM) + EPS);
    float4* o = (float4*)(out + (size_t)w * DM);
#pragma unroll
    for (int j = 0; j < 4; ++j) { const float4 gg = ((const float4*)g)[lane + 64 * j]; o[lane + 64 * j] = make_float4(v[j].x * r * gg.x, v[j].y * r * gg.y, v[j].z * r * gg.z, v[j].w * r * gg.w); }
}

struct GemmP {
    const float* A; int lda; const float* B; int ldb; float* C; int ldc; int M, N, K;
    const float* bias; const float* resid; const int* list; const int* cnt; int ashift; size_t bstride; int biasstride; int dual;
};
__global__ void __launch_bounds__(256) k_gemm(GemmP p) {
    __shared__ float As[16][68], Bs[16][64], Bs2[16][64];
    const int tid = threadIdx.x, ty = tid >> 4, tx = tid & 15, e = blockIdx.z;
    int M = p.M; const int* list = nullptr;
    const float* B = p.B + (size_t)e * p.bstride; const float* bias = p.bias ? p.bias + (size_t)e * p.biasstride : nullptr;
    if (p.list) { M = p.cnt[e]; list = p.list + (size_t)e * CAP; }
    const int m0 = blockIdx.y * 64, n0 = blockIdx.x * 64;
    if (m0 >= M) return;
    const int lr = tid >> 2, lk = (tid & 3) * 4;
    int arow = m0 + lr; bool avalid = arow < M;
    if (list && avalid) arow = list[arow] >> p.ashift;
    const float* Ap = p.A + (size_t)arow * p.lda + lk;
    const int bk = tid >> 4, bn = (tid & 15) * 4;
    float acc[4][4] = {}, acc2[4][4] = {};
    for (int k0 = 0; k0 < p.K; k0 += 16) {
        float4 a = avalid ? *(const float4*)(Ap + k0) : make_float4(0, 0, 0, 0);
        As[lk + 0][lr] = a.x; As[lk + 1][lr] = a.y; As[lk + 2][lr] = a.z; As[lk + 3][lr] = a.w;
        *(float4*)&Bs[bk][bn] = *(const float4*)(B + (size_t)(k0 + bk) * p.ldb + n0 + bn);
        if (p.dual) *(float4*)&Bs2[bk][bn] = *(const float4*)(B + (size_t)(k0 + bk) * p.ldb + n0 + bn + p.N);
        __syncthreads();
#pragma unroll
        for (int k = 0; k < 16; ++k) {
            const float4 av = *(const float4*)&As[k][ty * 4]; const float4 bv = *(const float4*)&Bs[k][tx * 4];
            const float aa[4] = {av.x, av.y, av.z, av.w}, bb[4] = {bv.x, bv.y, bv.z, bv.w};
#pragma unroll
            for (int i = 0; i < 4; ++i)
#pragma unroll
                for (int j = 0; j < 4; ++j) acc[i][j] += aa[i] * bb[j];
            if (p.dual) { const float4 cv = *(const float4*)&Bs2[k][tx * 4]; const float cc[4] = {cv.x, cv.y, cv.z, cv.w};
#pragma unroll
                for (int i = 0; i < 4; ++i)
#pragma unroll
                    for (int j = 0; j < 4; ++j) acc2[i][j] += aa[i] * cc[j]; }
        }
        __syncthreads();
    }
#pragma unroll
    for (int i = 0; i < 4; ++i) {
        int r = m0 + ty * 4 + i; if (r >= M) continue;
        const int crow = list ? list[r] : r;
        float o[4];
#pragma unroll
        for (int j = 0; j < 4; ++j) {
            const int c = n0 + tx * 4 + j; float v = acc[i][j] + (bias ? bias[c] : 0.f);
            if (p.dual) { float up = acc2[i][j] + bias[c + p.N]; float g = fminf(v, 7.f); up = fminf(fmaxf(up, -7.f), 7.f); v = (up + 1.f) * g * sigmoidf_(1.702f * g); }
            if (p.resid) v += p.resid[(size_t)crow * p.ldc + c];
            o[j] = v;
        }
        *(float4*)(p.C + (size_t)crow * p.ldc + n0 + tx * 4) = make_float4(o[0], o[1], o[2], o[3]);
    }
}

__global__ void k_qknorm(float* proj, const float* gq, const float* gk) {
    const int i = blockIdx.x * blockDim.x + threadIdx.x;
    if (i >= NTOK * 16) return;
    const int t = i >> 4, which = (i >> 3) & 1, h = i & 7;
    float* p = proj + (size_t)t * INC + which * 512 + h * 64; const float* g = which ? gk : gq;
    float s = 0.f; for (int d = 0; d < 64; ++d) s += p[d] * p[d];
    const float r = rsqrtf(s * (1.f / 64.f) + EPS) * (which ? 1.f : 0.125f);
    for (int d = 0; d < 64; ++d) p[d] = p[d] * r * g[d];
}

__global__ void __launch_bounds__(64) k_attn(const float* __restrict__ proj, float* __restrict__ o) {
    const int lane = threadIdx.x, tb = blockIdx.x % (SEQ / 64), bh = blockIdx.x / (SEQ / 64), b = bh >> 3, h = bh & 7;
    const int t = tb * 64 + lane;
    const float* base = proj + (size_t)b * SEQ * INC + h * 64;
    float q[64], acc[64];
#pragma unroll
    for (int d = 0; d < 64; ++d) { q[d] = base[(size_t)t * INC + d]; acc[d] = 0.f; }
    float R = 0.f;
    for (int s = tb * 64 + 62; s >= 0; --s) {
        const float* kr = base + (size_t)s * INC + 512; const float* vr = base + (size_t)s * INC + 1024;
        float z = 0.f;
#pragma unroll
        for (int d = 0; d < 64; ++d) z += q[d] * kr[d];
        if (s < t) {
            const float sp = fmaxf(z, 0.f) + log1pf(__expf(-fabsf(z)));
            const float w = __expf(z - sp + R);
#pragma unroll
            for (int d = 0; d < 64; ++d) acc[d] += w * vr[d];
            R -= sp;
        }
    }
    float* op = o + ((size_t)b * SEQ + t) * 512 + h * 64;
#pragma unroll
    for (int d = 0; d < 64; ++d) op[d] = acc[d];
}

__global__ void __launch_bounds__(64) k_ssm(const float* __restrict__ proj, const float* a_re, const float* a_im, const float* log_dt, const float* b_re, const float* b_im,
                                            const float* c_re, const float* c_im, const float* d_skip, float* __restrict__ yg) {
    const int p = threadIdx.x, b = blockIdx.x >> 5, g = blockIdx.x & 31;
    const float lr = a_re[g * 64 + p], li = a_im[g * 64 + p], dt = expf(log_dt[g]);
    const float mag = expf(lr * dt), ar = mag * cosf(li * dt), ai = mag * sinf(li * dt);
    const float den = lr * lr + li * li, nr = ar - 1.f, ni = ai, fr = (nr * lr + ni * li) / den, fi = (ni * lr - nr * li) / den;
    float bbr[16], bbi[16], cr[16], ci[16];
#pragma unroll
    for (int c = 0; c < 16; ++c) { const float br = b_re[(g * 64 + p) * 16 + c], bi = b_im[(g * 64 + p) * 16 + c]; bbr[c] = fr * br - fi * bi; bbi[c] = fr * bi + fi * br;
        cr[c] = c_re[(g * 16 + c) * 64 + p]; ci[c] = c_im[(g * 16 + c) * 64 + p]; }
    const float dsk = p < 16 ? d_skip[g * 16 + p] : 0.f;
    float hr = 0.f, hi = 0.f;
    for (int t = 0; t < SEQ; ++t) {
        const float* up = proj + ((size_t)b * SEQ + t) * INC + 1536 + g * 16;
        float u[16], xr = 0.f, xi = 0.f;
#pragma unroll
        for (int c = 0; c < 16; ++c) { u[c] = up[c]; xr += bbr[c] * u[c]; xi += bbi[c] * u[c]; }
        const float nhr = ar * hr - ai * hi + xr, nhi = ar * hi + ai * hr + xi; hr = nhr; hi = nhi;
        float mine = 0.f, myu = 0.f;
#pragma unroll
        for (int c = 0; c < 16; ++c) { const float s = wave_sum(cr[c] * hr - ci[c] * hi); if (p == c) { mine = s; myu = u[c]; } }
        if (p < 16) { const float y = mine + dsk * myu; const float gl = 0.5f * y * (1.f + tanhf(0.7978845608028654f * (y + 0.044715f * y * y * y)));
            yg[((size_t)b * SEQ + t) * 512 + g * 16 + p] = gl; }
    }
}

__global__ void k_mix(const float* __restrict__ proj, const float* __restrict__ ab, const float* __restrict__ zg, float* __restrict__ mixed, int gsig) {
    const size_t i = (size_t)blockIdx.x * blockDim.x + threadIdx.x; if (i >= (size_t)NTOK * DM) return;
    const size_t t = i >> 10; const int c = i & 1023;
    const float ga = proj[t * INC + 2048 + c], gs = proj[t * INC + 3072 + c];
    const float z1 = zg[t * 2048 + c], z2 = zg[t * 2048 + 1024 + c];
    mixed[i] = (gsig ? ga : sigmoidf_(ga)) * ab[i] + (gsig ? gs : sigmoidf_(gs)) * (z1 * sigmoidf_(z2));
}

__global__ void k_router(const float* __restrict__ h2, const float* __restrict__ wr, const float* __restrict__ br, int* cnt, int* list, float* topw) {
    const int lane = threadIdx.x & 63, t = (blockIdx.x * blockDim.x + threadIdx.x) >> 6; if (t >= NTOK) return;
    const int e = lane & 31, kh = lane >> 5; const float* hp = h2 + (size_t)t * DM + kh * 512; const float* wp = wr + (size_t)kh * 512 * 32 + e;
    float s = 0.f; for (int k = 0; k < 512; ++k) s += hp[k] * wp[(size_t)k * 32];
    s += __shfl_xor(s, 32); s += br[e];
    float v = s; int sel[4]; float sv[4];
#pragma unroll
    for (int r = 0; r < 4; ++r) {
        float bv = v; int bi = e;
#pragma unroll
        for (int o = 1; o < 32; o <<= 1) { const float ov = __shfl_xor(bv, o); const int oi = __shfl_xor(bi, o); if (ov > bv || (ov == bv && oi < bi)) { bv = ov; bi = oi; } }
        sel[r] = bi; sv[r] = bv; if (e == bi) v = -INFINITY;
    }
    const float m = sv[0]; float ex[4], den = 0.f;
#pragma unroll
    for (int r = 0; r < 4; ++r) { ex[r] = __expf(sv[r] - m); den += ex[r]; }
    if (lane < 4) { const int r = lane; const int ee = sel[r]; const int pos = atomicAdd(&cnt[ee], 1); list[ee * CAP + pos] = t * 4 + r; topw[t * 4 + r] = ex[r] / den; }
}

__global__ void k_combine(const float* __restrict__ x2, const float* __restrict__ y, const float* __restrict__ topw, float* __restrict__ x3) {
    const size_t i = (size_t)blockIdx.x * blockDim.x + threadIdx.x; if (i >= (size_t)NTOK * DM) return;
    const size_t t = i >> 10; const int c = i & 1023; float v = x2[i];
#pragma unroll
    for (int k = 0; k < 4; ++k) v += topw[t * 4 + k] * y[(t * 4 + k) * DM + c];
    x3[i] = v;
}
__global__ void k_final(const float* __restrict__ x3, const float* __restrict__ gate, const float* __restrict__ ple, float* __restrict__ out) {
    const size_t i = (size_t)blockIdx.x * blockDim.x + threadIdx.x; if (i >= (size_t)NTOK * DM) return;
    out[i] = x3[i] + sigmoidf_(gate[i]) * ple[i];
}

inline void gemm(hipStream_t st, const float* A, int lda, const float* B, int ldb, float* C, int ldc, int M, int N, int K, const float* bias, const float* resid) {
    GemmP p{}; p.A = A; p.lda = lda; p.B = B; p.ldb = ldb; p.C = C; p.ldc = ldc; p.M = M; p.N = N; p.K = K; p.bias = bias; p.resid = resid;
    hipLaunchKernelGGL(k_gemm, dim3(N / 64, M / 64, 1), dim3(256), 0, st, p);
}


inline void forward(void* const* d_in, float* out, unsigned char* ws, hipStream_t st, int from = 0, int gsig = 0, int pp_given = 0, const float* x2p = nullptr) {
    const float* x = (const float*)d_in[0]; const float* pin = (const float*)d_in[1];
#define IN(i) ((const float*)d_in[i])
    constexpr size_t MiB = 1u << 20;
    float* H = (float*)(ws + 0 * MiB); float* PROJ = (float*)(ws + 64 * MiB); float* O = (float*)(ws + 320 * MiB); float* YG = (float*)(ws + 352 * MiB);
    float* AB = (float*)(ws + 384 * MiB); float* ZG = (float*)(ws + 448 * MiB); float* MIX = (float*)(ws + 576 * MiB); float* X2 = (float*)(ws + 640 * MiB);
    int* CNT = (int*)(ws + 704 * MiB); int* LIST = (int*)(ws + 705 * MiB); float* TOPW = (float*)(ws + 708 * MiB);
    float* ACT = (float*)(ws + 64 * MiB); float* Y = (float*)(ws + 320 * MiB); float* X3 = (float*)(ws + 576 * MiB); float* GATE = (float*)(ws + 64 * MiB); float* PP = (float*)(ws + 720 * MiB);
    const int EW = NTOK * DM / 256;
    if (from <= 0) {
        hipLaunchKernelGGL(k_rmsnorm, dim3(NTOK / 4), dim3(256), 0, st, x, IN(2), H, NTOK);
        gemm(st, H, DM, IN(3), INC, PROJ, INC, NTOK, INC, DM, nullptr, nullptr);
        hipLaunchKernelGGL(k_qknorm, dim3(NTOK * 16 / 256), dim3(256), 0, st, PROJ, IN(4), IN(5));
    }
    if (from <= 1) {
        hipLaunchKernelGGL(k_attn, dim3(NB * 8 * (SEQ / 64)), dim3(64), 0, st, PROJ, O);
        hipLaunchKernelGGL(k_ssm, dim3(NB * 32), dim3(64), 0, st, PROJ, IN(7), IN(8), IN(9), IN(10), IN(11), IN(12), IN(13), IN(14), YG);
    }
    if (from <= 2) {
        gemm(st, O, 512, IN(6), DM, AB, DM, NTOK, DM, 512, nullptr, nullptr);
        gemm(st, YG, 512, IN(15), 2048, ZG, 2048, NTOK, 2048, 512, IN(16), nullptr);
        hipLaunchKernelGGL(k_mix, dim3(EW), dim3(256), 0, st, PROJ, AB, ZG, MIX, gsig);
        gemm(st, MIX, DM, IN(17), DM, X2, DM, NTOK, DM, DM, nullptr, x);
    }
    if (from <= 3) {
        const float* X2r = (from == 3) ? x2p : X2;
        hipMemsetAsync(CNT, 0, 256, st);
        hipLaunchKernelGGL(k_rmsnorm, dim3(NTOK / 4), dim3(256), 0, st, X2r, IN(18), H, NTOK);
        hipLaunchKernelGGL(k_router, dim3(NTOK / 4), dim3(256), 0, st, H, IN(19), IN(20), CNT, LIST, TOPW);
        { GemmP p{}; p.A = H; p.lda = DM; p.B = IN(21); p.ldb = 2048; p.C = ACT; p.ldc = DM; p.M = 0; p.N = 1024; p.K = DM; p.bias = IN(22); p.list = LIST; p.cnt = CNT; p.ashift = 2;
          p.bstride = (size_t)1024 * 2048; p.biasstride = 2048; p.dual = 1;
          hipLaunchKernelGGL(k_gemm, dim3(1024 / 64, CAP / 64, NE), dim3(256), 0, st, p); }
        { GemmP p{}; p.A = ACT; p.lda = DM; p.B = IN(23); p.ldb = DM; p.C = Y; p.ldc = DM; p.M = 0; p.N = 1024; p.K = DM; p.bias = IN(24); p.list = LIST; p.cnt = CNT; p.ashift = 0;
          p.bstride = (size_t)1024 * 1024; p.biasstride = 1024; p.dual = 0;
          hipLaunchKernelGGL(k_gemm, dim3(1024 / 64, CAP / 64, NE), dim3(256), 0, st, p); }
        hipLaunchKernelGGL(k_combine, dim3(EW), dim3(256), 0, st, X2r, Y, TOPW, X3);
    }
    {
        const float* X3r = (from == 4) ? out : X3;
        hipLaunchKernelGGL(k_rmsnorm, dim3(NTOK / 4), dim3(256), 0, st, X3r, IN(25), H, NTOK);
        gemm(st, H, DM, IN(26), DM, GATE, DM, NTOK, DM, DM, nullptr, nullptr);
        if (!pp_given) gemm(st, pin, 256, IN(27), DM, PP, DM, NTOK, DM, 256, nullptr, nullptr);
        hipLaunchKernelGGL(k_rmsnorm, dim3(NTOK / 4), dim3(256), 0, st, PP, IN(28), PP, NTOK);
        hipLaunchKernelGGL(k_final, dim3(EW), dim3(256), 0, st, X3r, GATE, PP, out);
    }
#undef IN
}
}
#include <hip/hip_runtime.h>
#include <cstdint>
#include <cstdio>
namespace mk {
#define LAS __attribute__((address_space(3)))
#define GAS __attribute__((address_space(1)))
typedef unsigned short bf16;
typedef short bf16x8 __attribute__((ext_vector_type(8)));
typedef float f32x4 __attribute__((ext_vector_type(4)));
typedef float f32x16 __attribute__((ext_vector_type(16)));
typedef float f32x2 __attribute__((ext_vector_type(2)));
typedef unsigned u32x4 __attribute__((ext_vector_type(4)));
typedef unsigned u32x2 __attribute__((ext_vector_type(2)));
typedef GAS unsigned gu32;

constexpr int NTOK = 16384, DM = 1024, SEQ = 2048, NBATCH = 8, INC = 4096, NE = 32, CAP = 16384, NHEAD = 8, HD = 64;
constexpr float EPS = 1e-6f;
constexpr int MAXRT = 288;
constexpr size_t MiB = 1u << 20;
constexpr size_t WS_CTL = 0, CTL_ZERO_BYTES = 1 * MiB;
constexpr size_t WS_LIST = 1 * MiB, WS_TOPW = 3 * MiB, WS_PSS = 4 * MiB, WS_A64 = 5 * MiB, WS_MTAB = 6 * MiB, WS_PTAB = 8 * MiB, WS_RTAB = 16 * MiB;
constexpr size_t WS_WIN = 26 * MiB, WS_WAB = 34 * MiB, WS_WGLU = 35 * MiB, WS_WOUT = 37 * MiB, WS_WPG = 39 * MiB, WS_WPP = 41 * MiB, WS_WUP = 42 * MiB, WS_WDN = 170 * MiB;
constexpr size_t WS_XN = 234 * MiB, WS_PBF = 266 * MiB, WS_PP = 274 * MiB, WS_X2 = 306 * MiB;
constexpr size_t WS_QH = 370 * MiB, WS_KH = 386 * MiB, WS_VT = 402 * MiB, WS_U = 418 * MiB, WS_SGA = 434 * MiB, WS_SGS = 466 * MiB, WS_O = 498 * MiB, WS_YG = 514 * MiB, WS_T1 = 530 * MiB, WS_MIX = 562 * MiB;
constexpr size_t WS_ACT = 370 * MiB, WS_YS = 594 * MiB, WS_END = 722 * MiB;
constexpr int CW_TMO = 0, CW_BAR = 4096, CW_CNT = 8192;
constexpr int RING_BYTES = 131072, LDSCTL_OFF = RING_BYTES, MISC_OFF = LDSCTL_OFF + 320, LDS_BYTES = 147456;
constexpr int NWAVES = 8;

#define RLX_AGENT __ATOMIC_RELAXED, __HIP_MEMORY_SCOPE_AGENT
#define LDS_WAIT() asm volatile("s_waitcnt lgkmcnt(0)" ::: "memory")
#define VM_WAIT() asm volatile("s_waitcnt vmcnt(0)" ::: "memory")
__device__ __forceinline__ unsigned f2bf(float f) { unsigned u = __builtin_bit_cast(unsigned, f); return (u + 0x7fffu + ((u >> 16) & 1u)) >> 16; }
__device__ __forceinline__ unsigned pk2(float lo, float hi) { return f2bf(lo) | (f2bf(hi) << 16); }
__device__ __forceinline__ float bflo(unsigned w) { return __builtin_bit_cast(float, w << 16); }
__device__ __forceinline__ float bfhi(unsigned w) { return __builtin_bit_cast(float, w & 0xffff0000u); }
__device__ __forceinline__ float sigm(float x) { return __builtin_amdgcn_rcpf(1.f + __expf(-x)); }
__device__ __forceinline__ float wave_sum(float v) {
#pragma unroll
    for (int o = 1; o < 64; o <<= 1) v += __shfl_xor(v, o);
    return v;
}

#define XB_TMO      128
#define XB_XCNT(j)  (256  + 64 * (j))
#define XB_XSUB(j)  (1280 + 64 * (j))
#define XB_XGEN(j)  (2304 + 64 * (j))
#define XB_TOP      3328
#define XB_TOPGEN   3392
#define XCD_BAR_WORDS 3456
#define XB_SPIN_CAP (1u << 18)
__device__ __forceinline__ unsigned xb_ld(unsigned* p)              { return __hip_atomic_load(p, __ATOMIC_RELAXED, __HIP_MEMORY_SCOPE_AGENT); }
__device__ __forceinline__ unsigned xb_add(unsigned* p, unsigned v) { return __hip_atomic_fetch_add(p, v, __ATOMIC_RELAXED, __HIP_MEMORY_SCOPE_AGENT); }
__device__ __forceinline__ unsigned xb_xcc_id() { return (unsigned)__builtin_amdgcn_s_getreg((3 << 11) | 20) & 0xFu; }
#define XB_SPIN(cond, bar) do { unsigned _sp = 0; while (cond) { __builtin_amdgcn_s_sleep(1); \
    if ((++_sp & 255u) == 0u) { if (xb_ld(&(bar)[XB_TMO])) break; if (_sp > XB_SPIN_CAP) { atomicAdd(&(bar)[XB_TMO], 1u); break; } } } } while (0)
struct XcdBarrier { unsigned* bar; unsigned x; volatile LAS unsigned* st; };
__device__ __forceinline__ XcdBarrier xcd_barrier_post(unsigned* bar, volatile LAS unsigned* st) {
    XcdBarrier b; b.bar = bar; b.x = xb_xcc_id(); b.st = st;
    if (threadIdx.x == 0) (void)xb_add(&bar[XB_XCNT(b.x)], 1u);
    return b;
}
__device__ __forceinline__ void xcd_barrier_complete(unsigned* bar, unsigned x, unsigned& nloc, unsigned& nx) {
    const unsigned G = gridDim.x * gridDim.y * gridDim.z;
    unsigned sum, cnt, mine, sp = 0u;
    for (;;) {
        sum = 0u; cnt = 0u; mine = 0u;
#pragma unroll
        for (unsigned j = 0; j < 16; ++j) { const unsigned c = xb_ld(&bar[XB_XCNT(j)]); sum += c; cnt += (c > 0u) ? 1u : 0u; mine = (j == x) ? c : mine; }
        if (sum == G) break;
        __builtin_amdgcn_s_sleep(1);
        if ((++sp & 255u) == 0u) { if (xb_ld(&bar[XB_TMO])) break; if (sp > XB_SPIN_CAP) { atomicAdd(&bar[XB_TMO], 1u); break; } }
    }
    nloc = mine > 0u ? mine : 1u; nx = cnt > 0u ? cnt : 1u;
}
__device__ __forceinline__ void xcd_barrier(const XcdBarrier& b) {
    asm volatile("s_waitcnt vmcnt(0)" ::: "memory");
    __syncthreads();
    if (threadIdx.x == 0) {
        unsigned* bar = b.bar;
        __builtin_amdgcn_s_waitcnt(0);
        unsigned nloc = b.st[0], nx = b.st[1];
        if (nloc == 0u) { xcd_barrier_complete(bar, b.x, nloc, nx); b.st[0] = nloc; b.st[1] = nx; }
        const unsigned old = xb_add(&bar[XB_XSUB(b.x)], 1u);
        const unsigned gen = old / nloc;
        if (old + 1u == (gen + 1u) * nloc) {
            __builtin_amdgcn_fence(__ATOMIC_RELEASE, "agent");
            asm volatile("s_waitcnt vmcnt(0)" ::: "memory");
            const unsigned og = xb_add(&bar[XB_TOP], 1u);
            const unsigned tg = og / nx;
            if (og + 1u == (tg + 1u) * nx) xb_add(&bar[XB_TOPGEN], 1u);
            else XB_SPIN(xb_ld(&bar[XB_TOPGEN]) == tg, bar);
            __builtin_amdgcn_fence(__ATOMIC_ACQUIRE, "agent");
            xb_add(&bar[XB_XGEN(b.x)], 1u);
            asm volatile("s_waitcnt vmcnt(0)" ::: "memory");
        } else {
            XB_SPIN(xb_ld(&bar[XB_XGEN(b.x)]) == gen, bar);
            __builtin_amdgcn_fence(__ATOMIC_ACQUIRE, "agent");
            asm volatile("s_waitcnt vmcnt(0)" ::: "memory");
        }
    }
    __syncthreads();
}

namespace pg8 {
constexpr int BM = 256, BK = 64, HALF = 128, HTB = HALF * BK * 2, STAGE_BYTES = 8 * HTB, NXCD = 8, WGM = 8;
__host__ __device__ __forceinline__ int lds_byte(int r, int c) { const int st = (r >> 4) * 2 + (c >> 5), rr = r & 15, cc = c & 31, ob = rr * 64 + cc * 2; return st * 1024 + (ob ^ (((ob >> 9) & 1) << 5)); }
__host__ __device__ __forceinline__ void stage_rc(int b, int& R, int& C) { const int st = b / 1024, sb = b % 1024, swz = sb ^ (((sb >> 9) & 1) << 5); R = (st >> 1) * 16 + swz / 64; C = (st & 1) * 32 + (swz % 64) / 2; }
__host__ __device__ __forceinline__ int perm32(int rho) { const int n = rho >> 4, i = rho & 15; return 8 * (i >> 2) + 4 * n + (i & 3); }

struct Unit { int pm, pn, pb, e, nv, lb; };
struct Gemm { const bf16* A; const bf16* Bt; int K; };

struct StaticOrder {
    int nM, nN, nwg, G, c;
    __device__ void init(int M, int N, int G_, int c_) { nM = M / BM; nN = N / BM; nwg = nM * nN; G = G_; c = c_; }
    __device__ bool next(int i, Unit& u) const {
        const long L = (long)i * G + c; if (L >= nwg) return false;
        int wgid = (int)L; { const int q = nwg / NXCD, r = nwg % NXCD, xcd = wgid % NXCD, off = wgid / NXCD; wgid = (xcd < r ? xcd * (q + 1) : r * (q + 1) + (xcd - r) * q) + off; }
        const int nig = WGM * nN, gid = wgid / nig, fm = gid * WGM, gsz = (nM - fm) < WGM ? (nM - fm) : WGM;
        u.pm = fm + ((wgid % nig) % gsz); u.pn = (wgid % nig) / gsz; u.pb = u.pn; u.e = 0; u.nv = 256; u.lb = 0; return true;
    }
    __device__ __forceinline__ unsigned arow(const Unit& u, int row) const { return (unsigned)(u.pm * 256 + row); }
};
struct MoeOrder {
    const LAS int* tst; const LAS int* cnt; const int* list; int nN, bx, G, shift;
    __device__ bool next(int i, Unit& u) const {
        int pn, rt;
        if (nN == 8) { pn = bx & 7; rt = (bx >> 3) + (G >> 3) * i; }
        else { pn = bx & 3; rt = 2 * ((bx >> 3) + (G >> 3) * i) + ((bx >> 2) & 1); }
        if (rt >= __builtin_amdgcn_readfirstlane(tst[32])) return false;
        int e = 0;
#pragma unroll 1
        for (int j = 1; j < 32; ++j) e = (__builtin_amdgcn_readfirstlane(tst[j]) <= rt) ? j : e;
        const int t0 = __builtin_amdgcn_readfirstlane(tst[e]), ce = __builtin_amdgcn_readfirstlane(cnt[e]);
        u.pm = rt; u.pn = pn; u.pb = e * nN + pn; u.e = e; const int r0 = (rt - t0) * 256; const int left = ce - r0; u.nv = left < 256 ? left : 256; u.lb = e * CAP + r0; return true;
    }
    __device__ __forceinline__ unsigned arow(const Unit& u, int row) const { const int r = row < u.nv ? row : u.nv - 1; return (unsigned)(list[u.lb + r] >> shift); }
};

__device__ __forceinline__ unsigned cvt_pk_bf16(float lo, float hi) { unsigned r; asm volatile("v_cvt_pk_bf16_f32 %0, %1, %2" : "=v"(r) : "v"(lo), "v"(hi)); return r; }

template <class Epi, class Sched, bool GATHER>
__device__ __forceinline__ void gemm_phase(LAS unsigned char* lds, const Gemm g, const Sched& S, const Epi& E) {
    const int tid = threadIdx.x, wid = __builtin_amdgcn_readfirstlane(tid >> 6), lane = tid & 63, wr = wid >> 2, wc = wid & 3, fr = lane & 15, fq = lane >> 4;
    const int K = g.K, nt = K / BK;
    int sR[2], sC[2]; unsigned voffB[2], voffA[2];
#pragma unroll
    for (int i = 0; i < 2; ++i) { stage_rc(tid * 16 + i * 8192, sR[i], sC[i]); const int Rb = Epi::PERM ? ((sR[i] & ~31) + perm32(sR[i] & 31)) : sR[i];
        voffB[i] = (unsigned)(Rb * K + sC[i]) * 2u; voffA[i] = (unsigned)(sR[i] * K + sC[i]) * 2u; }
    const unsigned kstep = (unsigned)(BK * 2);
    const unsigned hstep = (unsigned)HALF * (unsigned)K * 2u;
    const unsigned tstep = 2u * hstep;
    const unsigned ldsw = (unsigned)wid * 1024u;
    const int aoff = lds_byte(wr * 64 + fr, fq * 8), boff = lds_byte(wc * 32 + fr, fq * 8);
    const __amdgpu_buffer_rsrc_t rA = __builtin_amdgcn_make_buffer_rsrc((void*)g.A, 0, 0xfffff000u, 0x00020000);
    const __amdgpu_buffer_rsrc_t rB = __builtin_amdgcn_make_buffer_rsrc((void*)g.Bt, 0, 0xfffff000u, 0x00020000);
#define PG8_SA(b, h) (((b) * 2 + (h)) * HTB)
#define PG8_SB(b, h) ((4 + (b) * 2 + (h)) * HTB)
#define PG8_STAGE(bufoff, soff) do { _Pragma("unroll") for (int _i = 0; _i < 2; ++_i) \
        __builtin_amdgcn_raw_ptr_buffer_load_lds(rB, (LAS unsigned*)(lds + (bufoff) + ldsw + _i * 8192), 16, voffB[_i], (int)(soff), 0, 0); } while (0)
#define PG8_STAGEA(bufoff, soff, h, NX) do { _Pragma("unroll") for (int _i = 0; _i < 2; ++_i) { const unsigned _o = GATHER ? ((NX) ? vAn[h][_i] : vAc[h][_i]) : voffA[_i]; \
        __builtin_amdgcn_raw_ptr_buffer_load_lds(rA, (LAS unsigned*)(lds + (bufoff) + ldsw + _i * 8192), 16, _o, (int)((soff) + (GATHER ? 0u : (unsigned)(h) * hstep)), 0, 0); } } while (0)
#define PG8_LDA(dst, b, h) do { _Pragma("unroll") for (int m = 0; m < 4; ++m) _Pragma("unroll") for (int k = 0; k < 2; ++k) dst[m][k] = *(const LAS bf16x8*)(lds + PG8_SA(b, h) + aoff + m * 2048 + k * 1024); } while (0)
#define PG8_LDB(dst, b, h) do { _Pragma("unroll") for (int n = 0; n < 2; ++n) _Pragma("unroll") for (int k = 0; k < 2; ++k) dst[n][k] = *(const LAS bf16x8*)(lds + PG8_SB(b, h) + boff + n * 2048 + k * 1024); } while (0)
#define PG8_MMA(ai, bj, At, Bt) do { __builtin_amdgcn_s_setprio(1); _Pragma("unroll") for (int m = 0; m < 4; ++m) _Pragma("unroll") for (int n = 0; n < 2; ++n) _Pragma("unroll") for (int k = 0; k < 2; ++k) \
        acc[ai][bj][m][n] = __builtin_amdgcn_mfma_f32_16x16x32_bf16(Bt[n][k], At[m][k], acc[ai][bj][m][n], 0, 0, 0); __builtin_amdgcn_s_setprio(0); } while (0)
#define PG8_WAIT_V(n) asm volatile("s_waitcnt vmcnt(" #n ")" ::: "memory")
#define PG8_WAIT_L(n) asm volatile("s_waitcnt lgkmcnt(" #n ")" ::: "memory")
#define PG8_BAR __builtin_amdgcn_s_barrier()
#define PG8_SCHED __builtin_amdgcn_sched_barrier(0)
    Unit cur, nxt; int ui = 0;
    if (!S.next(0, cur)) return;
    unsigned vAc[2][2], vAn[2][2];
#define PG8_AOFF(dst, u) do { _Pragma("unroll") for (int _h = 0; _h < 2; ++_h) _Pragma("unroll") for (int _i = 0; _i < 2; ++_i) \
        dst[_h][_i] = S.arow(u, _h * HALF + sR[_i]) * (unsigned)(K * 2) + (unsigned)(sC[_i] * 2); } while (0)
    if (GATHER) { PG8_AOFF(vAc, cur); }
    f32x4 acc[2][2][4][2];
#pragma unroll
    for (int a = 0; a < 2; ++a)
#pragma unroll
        for (int b = 0; b < 2; ++b)
#pragma unroll
            for (int m = 0; m < 4; ++m)
#pragma unroll
                for (int n = 0; n < 2; ++n) acc[a][b][m][n] = (f32x4){0.f, 0.f, 0.f, 0.f};
    bf16x8 At[4][2], B0[2][2], B1[2][2];
    unsigned cA = GATHER ? 0u : (unsigned)cur.pm * tstep, cB = (unsigned)cur.pb * tstep;
    PG8_STAGE(PG8_SB(0, 0), cB); PG8_STAGE(PG8_SB(0, 1), cB + hstep); PG8_STAGEA(PG8_SA(0, 0), cA, 0, false); PG8_STAGEA(PG8_SA(0, 1), cA, 1, false);
    if (wr == 1) PG8_BAR;
    PG8_WAIT_V(2); PG8_BAR;
    PG8_STAGE(PG8_SB(1, 0), cB + kstep); PG8_STAGEA(PG8_SA(1, 0), cA + kstep, 0, false); PG8_STAGE(PG8_SB(1, 1), cB + hstep + kstep);
    PG8_WAIT_V(6); PG8_BAR;
    for (;;) {
        const bool has_next = S.next(ui + 1, nxt);
        const unsigned nA = has_next ? (GATHER ? 0u : (unsigned)nxt.pm * tstep) : cA, nB = has_next ? (unsigned)nxt.pb * tstep : cB;
        if (GATHER) { if (has_next) { PG8_AOFF(vAn, nxt); } else {
#pragma unroll
            for (int _h = 0; _h < 2; ++_h)
#pragma unroll
                for (int _i = 0; _i < 2; ++_i) vAn[_h][_i] = vAc[_h][_i]; } }
        for (int t = 0; t < nt; t += 2) {
            const bool last = (t == nt - 2);
            const unsigned a1 = cA + (unsigned)(t + 1) * kstep;
            const unsigned a2 = last ? nA : cA + (unsigned)(t + 2) * kstep, b2 = last ? nB : cB + (unsigned)(t + 2) * kstep;
            const unsigned a3 = a2 + kstep, b3 = b2 + kstep;
            PG8_LDB(B0, 0, 0); PG8_LDB(B1, 0, 1); PG8_SCHED; PG8_LDA(At, 0, 0); PG8_STAGEA(PG8_SA(1, 1), a1, 1, false);
            PG8_WAIT_V(8); PG8_WAIT_L(0); PG8_BAR; PG8_MMA(0, 0, At, B0); PG8_MMA(0, 1, At, B1); PG8_BAR; PG8_SCHED;
            PG8_LDA(At, 0, 1); PG8_STAGE(PG8_SB(0, 0), b2); PG8_STAGE(PG8_SB(0, 1), b2 + hstep); PG8_STAGEA(PG8_SA(0, 0), a2, 0, last);
            PG8_WAIT_V(8); PG8_WAIT_L(0); PG8_BAR; PG8_MMA(1, 0, At, B0); PG8_MMA(1, 1, At, B1); PG8_BAR; PG8_SCHED;
            PG8_LDB(B0, 1, 0); PG8_LDB(B1, 1, 1); PG8_SCHED; PG8_LDA(At, 1, 0); PG8_STAGEA(PG8_SA(0, 1), a2, 1, last);
            PG8_WAIT_V(8); PG8_WAIT_L(0); PG8_BAR; PG8_MMA(0, 0, At, B0); PG8_MMA(0, 1, At, B1); PG8_BAR; PG8_SCHED;
            PG8_LDA(At, 1, 1); PG8_STAGE(PG8_SB(1, 0), b3); PG8_STAGE(PG8_SB(1, 1), b3 + hstep); PG8_STAGEA(PG8_SA(1, 0), a3, 0, last);
            PG8_WAIT_V(8); PG8_WAIT_L(0); PG8_BAR; PG8_MMA(1, 0, At, B0); PG8_MMA(1, 1, At, B1); PG8_BAR; PG8_SCHED;
        }
        if (wr == 0) PG8_BAR;
        E(acc, cur, wr, wc, fr, fq);
        if (!has_next) break;
#pragma unroll
        for (int a = 0; a < 2; ++a)
#pragma unroll
            for (int b = 0; b < 2; ++b)
#pragma unroll
                for (int m = 0; m < 4; ++m)
#pragma unroll
                    for (int n = 0; n < 2; ++n) acc[a][b][m][n] = (f32x4){0.f, 0.f, 0.f, 0.f};
        cur = nxt; cA = nA; cB = nB; ++ui;
        if (GATHER) {
#pragma unroll
            for (int _h = 0; _h < 2; ++_h)
#pragma unroll
                for (int _i = 0; _i < 2; ++_i) vAc[_h][_i] = vAn[_h][_i]; }
        if (wr == 1) PG8_BAR;
    }
    PG8_WAIT_V(0);
    PG8_BAR;
#undef PG8_SA
#undef PG8_SB
#undef PG8_STAGE
#undef PG8_STAGEA
#undef PG8_LDA
#undef PG8_LDB
#undef PG8_MMA
#undef PG8_WAIT_V
#undef PG8_WAIT_L
#undef PG8_BAR
#undef PG8_SCHED
#undef PG8_AOFF
}
}
namespace epi {
using pg8::Unit; using pg8::HALF;
typedef const f32x4 (&AccRef)[2][2][4][2];
__device__ __forceinline__ u32x4 pack8(const f32x4 a, const f32x4 b) { u32x4 w; w.x = pk2(a[0], a[1]); w.y = pk2(a[2], a[3]); w.z = pk2(b[0], b[1]); w.w = pk2(b[2], b[3]); return w; }
__device__ __forceinline__ void unpack8(const u32x4 w, f32x4& a, f32x4& b) { a = (f32x4){bflo(w.x), bfhi(w.x), bflo(w.y), bfhi(w.y)}; b = (f32x4){bflo(w.z), bfhi(w.z), bflo(w.w), bfhi(w.w)}; }

struct EpiInProj {
    static constexpr bool PERM = true;
    bf16 *QH, *KH, *VT, *U, *SGA, *SGS; const float* gq; const float* gk;
    __device__ __forceinline__ void operator()(AccRef acc, const Unit& u, int wr, int wc, int fr, int fq) const {
        const int pn = u.pn;
        if (pn < 4) {
            const int which = pn >> 1, h = (pn & 1) * 4 + wc; const float* g = which ? gk : gq; bf16* dst = which ? KH : QH; const float qs = which ? 1.f : 0.125f * 1.4426950408889634f;
            f32x4 gv[2][2];
#pragma unroll
            for (int bj = 0; bj < 2; ++bj)
#pragma unroll
                for (int n = 0; n < 2; ++n) gv[bj][n] = *(const f32x4*)(g + 32 * bj + 8 * fq + 4 * n);
#pragma unroll
            for (int ai = 0; ai < 2; ++ai)
#pragma unroll
                for (int m = 0; m < 4; ++m) {
                    float ss = 0.f;
#pragma unroll
                    for (int bj = 0; bj < 2; ++bj)
#pragma unroll
                        for (int n = 0; n < 2; ++n) { const f32x4 v = acc[ai][bj][m][n]; ss += (v[0] * v[0] + v[1] * v[1]) + (v[2] * v[2] + v[3] * v[3]); }
                    ss += __shfl_xor(ss, 16); ss += __shfl_xor(ss, 32);
                    const float rs = rsqrtf(ss * (1.f / 64.f) + EPS) * qs;
                    const int row = u.pm * 256 + ai * HALF + wr * 64 + m * 16 + fr, b = row >> 11, s = row & 2047;
                    bf16* rp = dst + ((size_t)(b * NHEAD + h) * SEQ + s) * HD + 8 * fq;
#pragma unroll
                    for (int bj = 0; bj < 2; ++bj) *(u32x4*)(rp + 32 * bj) = pack8(acc[ai][bj][m][0] * rs * gv[bj][0], acc[ai][bj][m][1] * rs * gv[bj][1]);
                    asm volatile("" ::: "memory");
                }
        } else if (pn < 6) {
#pragma unroll
            for (int ai = 0; ai < 2; ++ai)
#pragma unroll
                for (int m = 0; m < 4; ++m) {
                    const int row = u.pm * 256 + ai * HALF + wr * 64 + m * 16 + fr, b = row >> 11, s = row & 2047;
#pragma unroll
                    for (int bj = 0; bj < 2; ++bj)
#pragma unroll
                        for (int n = 0; n < 2; ++n)
#pragma unroll
                            for (int i = 0; i < 4; ++i) { const int c = (pn - 4) * 256 + 128 * bj + 32 * wc + 8 * fq + 4 * n + i;
                                VT[((size_t)b * 512 + c) * SEQ + s] = (bf16)f2bf(acc[ai][bj][m][n][i]); }
                    asm volatile("" ::: "memory");
                }
        } else if (pn < 8) {
#pragma unroll
            for (int ai = 0; ai < 2; ++ai)
#pragma unroll
                for (int m = 0; m < 4; ++m) { const int row = u.pm * 256 + ai * HALF + wr * 64 + m * 16 + fr;
#pragma unroll
                    for (int bj = 0; bj < 2; ++bj) *(u32x4*)(U + (size_t)row * 512 + (pn - 6) * 256 + 128 * bj + 32 * wc + 8 * fq) = pack8(acc[ai][bj][m][0], acc[ai][bj][m][1]); asm volatile("" ::: "memory"); }
        } else {
            bf16* dst = pn < 12 ? SGA : SGS; const int ct = ((pn - 8) & 3) * 256;
#pragma unroll
            for (int ai = 0; ai < 2; ++ai)
#pragma unroll
                for (int m = 0; m < 4; ++m) { const int row = u.pm * 256 + ai * HALF + wr * 64 + m * 16 + fr;
#pragma unroll
                    for (int bj = 0; bj < 2; ++bj) { f32x4 a = acc[ai][bj][m][0], b = acc[ai][bj][m][1];
#pragma unroll
                        for (int i = 0; i < 4; ++i) { a[i] = sigm(a[i]); b[i] = sigm(b[i]); }
                        *(u32x4*)(dst + (size_t)row * DM + ct + 128 * bj + 32 * wc + 8 * fq) = pack8(a, b); } asm volatile("" ::: "memory"); }
        }
    }
};
struct EpiPle {
    static constexpr bool PERM = true;
    bf16* PP; float* PSS;
    __device__ __forceinline__ void operator()(AccRef acc, const Unit& u, int wr, int wc, int fr, int fq) const {
#pragma unroll
        for (int ai = 0; ai < 2; ++ai)
#pragma unroll
            for (int m = 0; m < 4; ++m) { const int row = u.pm * 256 + ai * HALF + wr * 64 + m * 16 + fr; float ss = 0.f;
#pragma unroll
                for (int bj = 0; bj < 2; ++bj) {
#pragma unroll
                    for (int n = 0; n < 2; ++n) { const f32x4 v = acc[ai][bj][m][n]; ss += (v[0] * v[0] + v[1] * v[1]) + (v[2] * v[2] + v[3] * v[3]); }
                    *(u32x4*)(PP + (size_t)row * DM + u.pn * 256 + 128 * bj + 32 * wc + 8 * fq) = pack8(acc[ai][bj][m][0], acc[ai][bj][m][1]); }
                ss += __shfl_xor(ss, 16); ss += __shfl_xor(ss, 32);
                if (fq == 0) PSS[(size_t)row * 16 + u.pn * 4 + wc] = ss; asm volatile("" ::: "memory"); }
    }
};
struct EpiT1 {
    static constexpr bool PERM = true;
    const bf16* SGA; bf16* T1;
    __device__ __forceinline__ void operator()(AccRef acc, const Unit& u, int wr, int wc, int fr, int fq) const {
#pragma unroll
        for (int ai = 0; ai < 2; ++ai)
#pragma unroll
            for (int m = 0; m < 4; ++m) { const size_t off = (size_t)(u.pm * 256 + ai * HALF + wr * 64 + m * 16 + fr) * DM + u.pn * 256 + 32 * wc + 8 * fq;
#pragma unroll
                for (int bj = 0; bj < 2; ++bj) { f32x4 ga, gb; unpack8(*(const u32x4*)(SGA + off + 128 * bj), ga, gb); *(u32x4*)(T1 + off + 128 * bj) = pack8(acc[ai][bj][m][0] * ga, acc[ai][bj][m][1] * gb); } asm volatile("" ::: "memory"); }
    }
};
struct EpiGlu {
    static constexpr bool PERM = true;
    const bf16* T1; const bf16* SGS; const float* bg; bf16* MIX;
    __device__ __forceinline__ void operator()(AccRef acc, const Unit& u, int wr, int wc, int fr, int fq) const {
        const int c0 = u.pn * 128 + 32 * wc + 8 * fq;
        const f32x4 b10 = *(const f32x4*)(bg + c0), b11 = *(const f32x4*)(bg + c0 + 4), b20 = *(const f32x4*)(bg + 1024 + c0), b21 = *(const f32x4*)(bg + 1024 + c0 + 4);
#pragma unroll
        for (int ai = 0; ai < 2; ++ai)
#pragma unroll
            for (int m = 0; m < 4; ++m) { const size_t off = (size_t)(u.pm * 256 + ai * HALF + wr * 64 + m * 16 + fr) * DM + c0;
                f32x4 ta, tb, sa, sb; unpack8(*(const u32x4*)(T1 + off), ta, tb); unpack8(*(const u32x4*)(SGS + off), sa, sb);
                f32x4 z1a = acc[ai][0][m][0] + b10, z1b = acc[ai][0][m][1] + b11, z2a = acc[ai][1][m][0] + b20, z2b = acc[ai][1][m][1] + b21;
#pragma unroll
                for (int i = 0; i < 4; ++i) { ta[i] += sa[i] * z1a[i] * sigm(z2a[i]); tb[i] += sb[i] * z1b[i] * sigm(z2b[i]); }
                *(u32x4*)(MIX + off) = pack8(ta, tb); asm volatile("" ::: "memory"); }
    }
};
struct EpiX2 {
    static constexpr bool PERM = false;
    const float* X; float* X2;
    __device__ __forceinline__ void operator()(AccRef acc, const Unit& u, int wr, int wc, int fr, int fq) const {
#pragma unroll
        for (int ai = 0; ai < 2; ++ai)
#pragma unroll
            for (int m = 0; m < 4; ++m) { const size_t off = (size_t)(u.pm * 256 + ai * HALF + wr * 64 + m * 16 + fr) * DM + u.pn * 256 + 32 * wc + 4 * fq;
#pragma unroll
                for (int bj = 0; bj < 2; ++bj)
#pragma unroll
                    for (int n = 0; n < 2; ++n) *(f32x4*)(X2 + off + 128 * bj + 16 * n) = *(const f32x4*)(X + off + 128 * bj + 16 * n) + acc[ai][bj][m][n]; asm volatile("" ::: "memory"); }
    }
};
struct EpiUp {
    static constexpr bool PERM = true;
    const float* bup; bf16* ACT;
    __device__ __forceinline__ void operator()(AccRef acc, const Unit& u, int wr, int wc, int fr, int fq) const {
        const int c0 = u.pn * 128 + 32 * wc + 8 * fq; const float* bg = bup + (size_t)u.e * 2048;
        const f32x4 b10 = *(const f32x4*)(bg + c0), b11 = *(const f32x4*)(bg + c0 + 4), b20 = *(const f32x4*)(bg + 1024 + c0), b21 = *(const f32x4*)(bg + 1024 + c0 + 4);
#pragma unroll
        for (int ai = 0; ai < 2; ++ai)
#pragma unroll
            for (int m = 0; m < 4; ++m) { const size_t off = (size_t)(u.pm * 256 + ai * HALF + wr * 64 + m * 16 + fr) * DM + c0;
                f32x4 ga = acc[ai][0][m][0] + b10, gb = acc[ai][0][m][1] + b11, ua = acc[ai][1][m][0] + b20, ub = acc[ai][1][m][1] + b21;
#pragma unroll
                for (int i = 0; i < 4; ++i) { const float g0 = fminf(ga[i], 7.f), g1 = fminf(gb[i], 7.f), u0 = fminf(fmaxf(ua[i], -7.f), 7.f), u1 = fminf(fmaxf(ub[i], -7.f), 7.f);
                    ga[i] = (u0 + 1.f) * g0 * sigm(1.702f * g0); gb[i] = (u1 + 1.f) * g1 * sigm(1.702f * g1); }
                *(u32x4*)(ACT + off) = pack8(ga, gb); asm volatile("" ::: "memory"); }
    }
};
struct EpiDown {
    static constexpr bool PERM = true;
    const float* bdn; const int* list; bf16* YS;
    __device__ __forceinline__ void operator()(AccRef acc, const Unit& u, int wr, int wc, int fr, int fq) const {
        const int c0 = u.pn * 256 + 32 * wc + 8 * fq; const float* bb = bdn + (size_t)u.e * 1024;
        f32x4 bv[2][2];
#pragma unroll
        for (int bj = 0; bj < 2; ++bj)
#pragma unroll
            for (int n = 0; n < 2; ++n) bv[bj][n] = *(const f32x4*)(bb + c0 + 128 * bj + 4 * n);
#pragma unroll
        for (int ai = 0; ai < 2; ++ai)
#pragma unroll
            for (int m = 0; m < 4; ++m) { const int rl = ai * HALF + wr * 64 + m * 16 + fr;
                if (rl < u.nv) { const int pair = list[u.lb + rl];
#pragma unroll
                    for (int bj = 0; bj < 2; ++bj) *(u32x4*)(YS + (size_t)pair * DM + c0 + 128 * bj) = pack8(acc[ai][bj][m][0] + bv[bj][0], acc[ai][bj][m][1] + bv[bj][1]); } asm volatile("" ::: "memory"); }
    }
};
struct EpiFinal {
    static constexpr bool PERM = false;
    float* OUT; const bf16* PP; const float* PSS; const float* gpost;
    __device__ __forceinline__ void operator()(AccRef acc, const Unit& u, int wr, int wc, int fr, int fq) const {
        const int cb = u.pn * 256 + 32 * wc + 4 * fq;
        f32x4 gp[2][2];
#pragma unroll
        for (int bj = 0; bj < 2; ++bj)
#pragma unroll
            for (int n = 0; n < 2; ++n) gp[bj][n] = *(const f32x4*)(gpost + cb + 128 * bj + 16 * n);
#pragma unroll
        for (int ai = 0; ai < 2; ++ai)
#pragma unroll
            for (int m = 0; m < 4; ++m) { const int row = u.pm * 256 + ai * HALF + wr * 64 + m * 16 + fr; const size_t off = (size_t)row * DM + cb;
                const f32x4* ps = (const f32x4*)(PSS + (size_t)row * 16); const f32x4 p0 = ps[0], p1 = ps[1], p2 = ps[2], p3 = ps[3];
                const float tot = ((p0[0] + p0[1]) + (p0[2] + p0[3])) + ((p1[0] + p1[1]) + (p1[2] + p1[3])) + ((p2[0] + p2[1]) + (p2[2] + p2[3])) + ((p3[0] + p3[1]) + (p3[2] + p3[3]));
                const float rp = rsqrtf(tot * (1.f / DM) + EPS);
#pragma unroll
                for (int bj = 0; bj < 2; ++bj)
#pragma unroll
                    for (int n = 0; n < 2; ++n) { const u32x2 pw = *(const u32x2*)(PP + off + 128 * bj + 16 * n); const f32x4 pv = (f32x4){bflo(pw.x), bfhi(pw.x), bflo(pw.y), bfhi(pw.y)};
                        f32x4 o = *(const f32x4*)(OUT + off + 128 * bj + 16 * n); const f32x4 a = acc[ai][bj][m][n];
#pragma unroll
                        for (int i = 0; i < 4; ++i) o[i] += sigm(a[i]) * (pv[i] * rp * gp[bj][n][i]);
                        *(f32x4*)(OUT + off + 128 * bj + 16 * n) = o; } asm volatile("" ::: "memory"); }
    }
};
}
struct Frame {
    LAS unsigned char* lds; gu32* ctl; int tid, lane, wave, G, bx;
    unsigned char* ws; float* out;
};
constexpr int PTAB_OFF = LDSCTL_OFF + 1024;
__device__ __forceinline__ const float* fin_load(const Frame& F, int i) {
    const unsigned long long v = ((const LAS unsigned long long*)(F.lds + PTAB_OFF))[i];
    const unsigned lo = __builtin_amdgcn_readfirstlane((unsigned)v), hi = __builtin_amdgcn_readfirstlane((unsigned)(v >> 32));
    return (const float*)(((unsigned long long)hi << 32) | lo);
}
#define FIN(i) (fin_load(F, (i)))
template <class T> __device__ __forceinline__ T* wsp(const Frame& F, size_t off) { return (T*)(F.ws + off); }

__device__ __forceinline__ void p0_transpose_item(const float* W, int K, int N, bf16* WT, int prow, LAS float* scr, int kb, int nb, int lane) {
    const int k0 = 64 * kb, n0 = 32 * nb;
#pragma unroll 8
    for (int i = 0; i < 32; ++i) { const int kk = 2 * i + (lane >> 5); scr[kk * 33 + (lane & 31)] = W[(size_t)(k0 + kk) * N + n0 + (lane & 31)]; }
    LDS_WAIT(); asm volatile("" ::: "memory");
    const int c = lane & 7;
#pragma unroll
    for (int j = 0; j < 4; ++j) { const int n = (lane >> 3) + 8 * j; const LAS float* s = scr + (8 * c) * 33 + n;
        u32x4 o; o.x = pk2(s[0 * 33], s[1 * 33]); o.y = pk2(s[2 * 33], s[3 * 33]); o.z = pk2(s[4 * 33], s[5 * 33]); o.w = pk2(s[6 * 33], s[7 * 33]);
        *(GAS u32x4*)(WT + (size_t)(prow + n) * K + k0 + 8 * c) = o; }
    LDS_WAIT(); asm volatile("" ::: "memory");
}
__device__ __forceinline__ int prow0(int kind, int n0) {
    if (kind == 1) { if (n0 < 1024) { const int pn = n0 >> 8, wcb = (n0 >> 6) & 3, bjb = (n0 >> 5) & 1; return 256 * pn + 128 * bjb + 32 * wcb; } return n0; }
    if (kind == 2) { const int bj = n0 >> 10, rem = n0 & 1023; return 256 * (rem >> 7) + 128 * bj + (rem & 127); }
    return n0;
}
__device__ __forceinline__ void abar_pow(float lr, float li, float dt, int n, float& er, float& ei) {
    const double rev = (double)li * (double)dt * (double)n * 0.15915494309189535;
    const float f = (float)(rev - __builtin_rint(rev));
    const float mag = expf(lr * dt * (float)n);
    er = mag * __builtin_amdgcn_cosf(f); ei = mag * __builtin_amdgcn_sinf(f);
}
__device__ __forceinline__ void zoh_f(float lr, float li, float dt, float& fr, float& fi) {
    float ar, ai; abar_pow(lr, li, dt, 1, ar, ai);
    const float den = lr * lr + li * li, nr = ar - 1.f; fr = (nr * lr + ai * li) / den; fi = (ai * lr - nr * li) / den;
}
constexpr int IT_WIN = 16 * 128, IT_WAB = 8 * 32, IT_WGLU = 8 * 64, IT_WOUT = 16 * 32, IT_WPG = 16 * 32, IT_WPP = 4 * 32, IT_WUP1 = 16 * 64, IT_WDN1 = 16 * 32;
constexpr int IT_T0 = 0, IT_T1 = IT_T0 + IT_WIN, IT_T2 = IT_T1 + IT_WAB, IT_T3 = IT_T2 + IT_WGLU, IT_T4 = IT_T3 + IT_WOUT, IT_T5 = IT_T4 + IT_WPG, IT_T6 = IT_T5 + IT_WPP, IT_T7 = IT_T6 + 32 * IT_WUP1,
              IT_T8 = IT_T7 + 32 * IT_WDN1;
constexpr int IT_XN = IT_T8, IT_PBF = IT_XN + NTOK, IT_PT = IT_PBF + 4096, IT_RT = IT_PT + 2048, IT_MT = IT_RT + 2048, IT_A64 = IT_MT + 32 * 65, IT_END = IT_A64 + 32;
struct TItem { const float* src; bf16* dst; int N, K; };
__device__ __forceinline__ void p0_decode(Frame& F, int it, TItem& t) {
    const float* W; bf16* WT; int K, N, kind, r;
    if (it < IT_T1) { r = it - IT_T0; W = FIN(3); K = 1024; N = 4096; kind = 1; WT = wsp<bf16>(F, WS_WIN); }
    else if (it < IT_T2) { r = it - IT_T1; W = FIN(6); K = 512; N = 1024; kind = 0; WT = wsp<bf16>(F, WS_WAB); }
    else if (it < IT_T3) { r = it - IT_T2; W = FIN(15); K = 512; N = 2048; kind = 2; WT = wsp<bf16>(F, WS_WGLU); }
    else if (it < IT_T4) { r = it - IT_T3; W = FIN(17); K = 1024; N = 1024; kind = 0; WT = wsp<bf16>(F, WS_WOUT); }
    else if (it < IT_T5) { r = it - IT_T4; W = FIN(26); K = 1024; N = 1024; kind = 0; WT = wsp<bf16>(F, WS_WPG); }
    else if (it < IT_T6) { r = it - IT_T5; W = FIN(27); K = 256; N = 1024; kind = 0; WT = wsp<bf16>(F, WS_WPP); }
    else if (it < IT_T7) { r = it - IT_T6; const int e = r / IT_WUP1; r -= e * IT_WUP1; W = FIN(21) + (size_t)e * 1024 * 2048; K = 1024; N = 2048; kind = 2; WT = wsp<bf16>(F, WS_WUP) + (size_t)e * 2048 * 1024; }
    else { r = it - IT_T7; const int e = r / IT_WDN1; r -= e * IT_WDN1; W = FIN(23) + (size_t)e * 1024 * 1024; K = 1024; N = 1024; kind = 0; WT = wsp<bf16>(F, WS_WDN) + (size_t)e * 1024 * 1024; }
    const int nblk = N / 32, kb = r / nblk, nb = r % nblk;
    t.src = W + (size_t)(64 * kb) * N + 32 * nb; t.dst = WT + (size_t)prow0(kind, 32 * nb) * K + 64 * kb; t.N = N; t.K = K;
}
__device__ __forceinline__ void p0_prologue(Frame& F) {
    LAS float* scr = (LAS float*)(F.lds + F.wave * 16384);
    const int lane = F.lane, gw = F.bx * NWAVES + F.wave, NGW = F.G * NWAVES;
    {
        int it = gw; TItem cur, nx; f32x4 v[8], vn[8];
        const int lr = lane >> 3, lc = 4 * (lane & 7);
        if (it < IT_T8) { p0_decode(F, it, cur);
#pragma unroll
            for (int i = 0; i < 8; ++i) v[i] = *(const GAS f32x4*)(cur.src + (size_t)(8 * i + lr) * cur.N + lc); }
        while (it < IT_T8) {
            const int nit = it + NGW; const bool has = nit < IT_T8;
            if (has) { p0_decode(F, nit, nx);
#pragma unroll
                for (int i = 0; i < 8; ++i) vn[i] = *(const GAS f32x4*)(nx.src + (size_t)(8 * i + lr) * nx.N + lc); }
#pragma unroll
            for (int i = 0; i < 8; ++i) { LAS float* d = scr + (8 * i + lr) * 33 + lc; d[0] = v[i][0]; d[1] = v[i][1]; d[2] = v[i][2]; d[3] = v[i][3]; }
            LDS_WAIT(); asm volatile("" ::: "memory");
            const int c = lane & 7;
#pragma unroll
            for (int j = 0; j < 4; ++j) { const int n = (lane >> 3) + 8 * j; const LAS float* s = scr + (8 * c) * 33 + n;
                u32x4 o; o.x = pk2(s[0 * 33], s[1 * 33]); o.y = pk2(s[2 * 33], s[3 * 33]); o.z = pk2(s[4 * 33], s[5 * 33]); o.w = pk2(s[6 * 33], s[7 * 33]);
                *(GAS u32x4*)(cur.dst + (size_t)n * cur.K + 8 * c) = o; }
            LDS_WAIT(); asm volatile("" ::: "memory");
            if (has) { cur = nx;
#pragma unroll
                for (int i = 0; i < 8; ++i) v[i] = vn[i]; }
            it = nit;
        }
    }
    for (int it = IT_T8 + gw; it < IT_END; it += NGW) {
        if (it < IT_PBF) {

            const int row = it - IT_XN; const GAS f32x4* xr = (const GAS f32x4*)(FIN(0) + (size_t)row * DM) + lane; const GAS f32x4* gr = (const GAS f32x4*)FIN(2) + lane;
            f32x4 v[4]; float s = 0.f;
#pragma unroll
            for (int j = 0; j < 4; ++j) { v[j] = xr[64 * j]; s += (v[j].x * v[j].x + v[j].y * v[j].y) + (v[j].z * v[j].z + v[j].w * v[j].w); }
            const float r = rsqrtf(wave_sum(s) * (1.f / DM) + EPS);
            GAS u32x2* o8 = (GAS u32x2*)(wsp<bf16>(F, WS_XN) + (size_t)row * DM) + lane;
#pragma unroll
            for (int j = 0; j < 4; ++j) { const f32x4 g = gr[64 * j]; u32x2 w; w.x = pk2(v[j].x * r * g.x, v[j].y * r * g.y); w.y = pk2(v[j].z * r * g.z, v[j].w * r * g.w); o8[64 * j] = w; }
        } else if (it < IT_PT) {
            const int q = it - IT_PBF; const GAS f32x4* pr = (const GAS f32x4*)(FIN(1) + (size_t)q * 1024) + lane; GAS u32x2* o8 = (GAS u32x2*)(wsp<bf16>(F, WS_PBF) + (size_t)q * 1024) + lane;
#pragma unroll
            for (int j = 0; j < 4; ++j) { const f32x4 v = pr[64 * j]; u32x2 w; w.x = pk2(v.x, v.y); w.y = pk2(v.z, v.w); o8[64 * j] = w; }
        } else {
            int r, kindt; if (it < IT_RT) { r = it - IT_PT; kindt = 0; } else if (it < IT_MT) { r = it - IT_RT; kindt = 1; } else if (it < IT_A64) { r = it - IT_MT; kindt = 2; } else { r = it - IT_A64; kindt = 3; }
            const int g = (kindt == 2) ? r / 65 : (kindt == 3 ? r : r >> 6), sub = (kindt == 2) ? r % 65 : (r & 63), p = lane;
            const float lr = FIN(7)[g * 64 + p], li = FIN(8)[g * 64 + p], dt = expf(FIN(9)[g]);
            if (kindt == 3) { float er, ei; abar_pow(lr, li, dt, 64, er, ei); float* a = wsp<float>(F, WS_A64) + (g * 64 + p) * 2; a[0] = er; a[1] = ei; continue; }
            float fr, fi; zoh_f(lr, li, dt, fr, fi);
            if (kindt == 0) {
                const int j = sub; float er, ei; abar_pow(lr, li, dt, 63 - j, er, ei);
                float re[16], im[16];
#pragma unroll
                for (int c = 0; c < 16; ++c) { const float br = FIN(10)[(g * 64 + p) * 16 + c], bi = FIN(11)[(g * 64 + p) * 16 + c]; const float bbr = fr * br - fi * bi, bbi = fr * bi + fi * br;
                    re[c] = er * bbr - ei * bbi; im[c] = er * bbi + ei * bbr; }
                bf16* P = wsp<bf16>(F, WS_PTAB) + (size_t)g * 128 * 1024;
                u32x4 w0, w1; w0.x = pk2(re[0], re[1]); w0.y = pk2(re[2], re[3]); w0.z = pk2(re[4], re[5]); w0.w = pk2(re[6], re[7]); w1.x = pk2(re[8], re[9]); w1.y = pk2(re[10], re[11]); w1.z = pk2(re[12], re[13]); w1.w = pk2(re[14], re[15]);
                *(u32x4*)(P + (size_t)p * 1024 + j * 16) = w0; *(u32x4*)(P + (size_t)p * 1024 + j * 16 + 8) = w1;
                w0.x = pk2(im[0], im[1]); w0.y = pk2(im[2], im[3]); w0.z = pk2(im[4], im[5]); w0.w = pk2(im[6], im[7]); w1.x = pk2(im[8], im[9]); w1.y = pk2(im[10], im[11]); w1.z = pk2(im[12], im[13]); w1.w = pk2(im[14], im[15]);
                *(u32x4*)(P + (size_t)(64 + p) * 1024 + j * 16) = w0; *(u32x4*)(P + (size_t)(64 + p) * 1024 + j * 16 + 8) = w1;
            } else if (kindt == 1) {
                const int t = sub; float er, ei; abar_pow(lr, li, dt, t + 1, er, ei);
                bf16* R = wsp<bf16>(F, WS_RTAB) + (size_t)g * 1024 * 128;
#pragma unroll 4
                for (int c = 0; c < 16; ++c) { const float cr = FIN(12)[(g * 16 + c) * 64 + p], ci = FIN(13)[(g * 16 + c) * 64 + p];
                    R[(size_t)(t * 16 + c) * 128 + p] = (bf16)f2bf(cr * er - ci * ei); R[(size_t)(t * 16 + c) * 128 + 64 + p] = (bf16)f2bf(-(cr * ei + ci * er)); }
            } else {
                const int dd = sub; bf16* M = wsp<bf16>(F, WS_MTAB) + ((size_t)g * 65 + dd) * 256;
                if (dd == 0) { for (int k = 0; k < 4; ++k) M[lane + 64 * k] = 0; continue; }
                float er, ei; abar_pow(lr, li, dt, dd - 1, er, ei);
                float X[16], Y[16];
#pragma unroll
                for (int c = 0; c < 16; ++c) { const float br = FIN(10)[(g * 64 + p) * 16 + c], bi = FIN(11)[(g * 64 + p) * 16 + c]; const float bbr = fr * br - fi * bi, bbi = fr * bi + fi * br;
                    X[c] = er * bbr - ei * bbi; Y[c] = er * bbi + ei * bbr; }
                float keep[4] = {0.f, 0.f, 0.f, 0.f};
#pragma unroll
                for (int c = 0; c < 16; ++c) { const float cr = FIN(12)[(g * 16 + c) * 64 + p], ci = FIN(13)[(g * 16 + c) * 64 + p];
#pragma unroll
                    for (int c2 = 0; c2 < 16; ++c2) { const float s = wave_sum(cr * X[c2] - ci * Y[c2]); const int e = c * 16 + c2; if ((e & 63) == lane) keep[e >> 6] = s; } }
#pragma unroll
                for (int k = 0; k < 4; ++k) M[lane + 64 * k] = (bf16)f2bf(keep[k]);
            }
        }
    }
}

__device__ __forceinline__ int crow(int r, int hi) { return (r & 3) + 8 * (r >> 2) + 4 * hi; }
constexpr float LOG2E = 1.4426950408889634f;
constexpr float ATTN_DEAD = -160.f;
template <bool EARLY_EXIT>
__device__ __forceinline__ void attn_tile(const bf16* __restrict__ QH, const bf16* __restrict__ KH, const bf16* __restrict__ VT, bf16* __restrict__ O, int bh, int qt, int lane) {
    const int r32 = lane & 31, hi = lane >> 5;
    const bf16* Qp = QH + ((size_t)bh * SEQ + qt * 32 + r32) * HD + hi * 8;
    bf16x8 qf[4];
#pragma unroll
    for (int ks = 0; ks < 4; ++ks) qf[ks] = *(const bf16x8*)(Qp + ks * 16);
    bf16x8 tri[2];
#pragma unroll
    for (int s = 0; s < 2; ++s)
#pragma unroll
        for (int jj = 0; jj < 8; ++jj) { const int jp = 16 * s + 8 * (jj >> 2) + 4 * hi + (jj & 3); tri[s][jj] = (jp > r32) ? (short)0x3f80 : (short)0; }
    f32x16 oT[2]; oT[0] = f32x16{}; oT[1] = f32x16{};
    float R = 0.f;
    for (int kb = qt; kb >= 0; --kb) {
        const bf16* Kp = KH + ((size_t)bh * SEQ + kb * 32 + r32) * HD + hi * 8;
        f32x16 st = f32x16{};
#pragma unroll
        for (int ks = 0; ks < 4; ++ks) { const bf16x8 kf = *(const bf16x8*)(Kp + ks * 16); st = __builtin_amdgcn_mfma_f32_32x32x16_bf16(kf, qf[ks], st, 0, 0, 0); }
        f32x16 sp, lg;
        const bool diag = (kb == qt);
#pragma unroll
        for (int r = 0; r < 16; ++r) {
            const float z = st[r]; const float e = __builtin_amdgcn_exp2f(-__builtin_fabsf(z)); const float l2 = __builtin_amdgcn_logf(1.f + e);
            float s_ = __builtin_fmaxf(z, 0.f) + l2, g_ = __builtin_fminf(z, 0.f) - l2;
            if (diag && crow(r, hi) >= r32) { s_ = 0.f; g_ = -1e30f; }
            sp[r] = s_; lg[r] = g_;
        }
        f32x16 later;
#pragma unroll
        for (int r = 0; r < 16; ++r) later[r] = R;
        {
            u32x4 w0, w1;
            w0.x = pk2(-sp[0], -sp[1]); w0.y = pk2(-sp[2], -sp[3]); w0.z = pk2(-sp[4], -sp[5]); w0.w = pk2(-sp[6], -sp[7]);
            w1.x = pk2(-sp[8], -sp[9]); w1.y = pk2(-sp[10], -sp[11]); w1.z = pk2(-sp[12], -sp[13]); w1.w = pk2(-sp[14], -sp[15]);
            later = __builtin_amdgcn_mfma_f32_32x32x16_bf16(tri[0], __builtin_bit_cast(bf16x8, w0), later, 0, 0, 0);
            later = __builtin_amdgcn_mfma_f32_32x32x16_bf16(tri[1], __builtin_bit_cast(bf16x8, w1), later, 0, 0, 0);
        }
        u32x4 p0, p1;
        {
            float w[16];
#pragma unroll
            for (int r = 0; r < 16; ++r) w[r] = __builtin_amdgcn_exp2f(lg[r] + later[r]);
            p0.x = pk2(w[0], w[1]); p0.y = pk2(w[2], w[3]); p0.z = pk2(w[4], w[5]); p0.w = pk2(w[6], w[7]);
            p1.x = pk2(w[8], w[9]); p1.y = pk2(w[10], w[11]); p1.z = pk2(w[12], w[13]); p1.w = pk2(w[14], w[15]);
        }
#pragma unroll
        for (int mt = 0; mt < 2; ++mt) {
            const bf16* Vp = VT + ((size_t)bh * HD + 32 * mt + r32) * SEQ + kb * 32 + 4 * hi;
            const u32x2 a0 = *(const u32x2*)(Vp), a1 = *(const u32x2*)(Vp + 8), a2 = *(const u32x2*)(Vp + 16), a3 = *(const u32x2*)(Vp + 24);
            const u32x4 v0 = (u32x4){a0.x, a0.y, a1.x, a1.y}, v1 = (u32x4){a2.x, a2.y, a3.x, a3.y};
            oT[mt] = __builtin_amdgcn_mfma_f32_32x32x16_bf16(__builtin_bit_cast(bf16x8, v0), __builtin_bit_cast(bf16x8, p0), oT[mt], 0, 0, 0);
            oT[mt] = __builtin_amdgcn_mfma_f32_32x32x16_bf16(__builtin_bit_cast(bf16x8, v1), __builtin_bit_cast(bf16x8, p1), oT[mt], 0, 0, 0);
        }
        R = __shfl(later[0] - sp[0], r32);
        if (EARLY_EXIT) { if (__all(R < ATTN_DEAD)) break; }
    }
    bf16* Op = O + ((size_t)(bh >> 3) * SEQ + qt * 32 + r32) * 512 + (bh & 7) * HD + 4 * hi;
#pragma unroll
    for (int mt = 0; mt < 2; ++mt)
#pragma unroll
        for (int q = 0; q < 4; ++q) { u32x2 w; w.x = pk2(oT[mt][4 * q], oT[mt][4 * q + 1]); w.y = pk2(oT[mt][4 * q + 2], oT[mt][4 * q + 3]); *(u32x2*)(Op + 32 * mt + 8 * q) = w; }
}
constexpr int SSM_U = 0, SSM_MT = 65536, SSM_SLOC = SSM_MT + 33280, SSM_SPREV = SSM_SLOC + 16384, SSM_END = SSM_SPREV + 8192;
static_assert(SSM_END <= RING_BYTES, "ssm lds");
__device__ __forceinline__ void ssm_item(Frame& F, int b, int g) {
    LAS unsigned char* lds = F.lds; const int tid = F.tid, lane = F.lane, w = F.wave;
    const bf16* U = wsp<bf16>(F, WS_U);
#pragma unroll
    for (int i = 0; i < 8; ++i) { const int q = tid + 512 * i, row = q >> 1, half = q & 1, n = row >> 6, j = row & 63;
        *(LAS u32x4*)(lds + SSM_U + ((j * 32 + n) * 16 + half * 8) * 2) = *(const u32x4*)(U + ((size_t)(b * SEQ + row)) * 512 + g * 16 + half * 8); }
    { const u32x4* src = (const u32x4*)(wsp<bf16>(F, WS_MTAB) + (size_t)g * 65 * 256);
      for (int q = tid; q < 2080; q += 512) *(LAS u32x4*)(lds + SSM_MT + q * 16) = src[q]; }
    __syncthreads();
    const int fr = lane & 15, fq = lane >> 4;
    {
        f32x4 a0 = (f32x4){0.f, 0.f, 0.f, 0.f}, a1 = a0;
        const bf16* Pg = wsp<bf16>(F, WS_PTAB) + (size_t)g * 128 * 1024 + (size_t)(16 * w + fr) * 1024 + 8 * fq;
#pragma unroll 4
        for (int j0 = 0; j0 < 32; ++j0) {
            const bf16x8 af = *(const bf16x8*)(Pg + 32 * j0);
            const int ub = SSM_U + (((2 * j0 + (lane >> 5)) * 32 + fr) * 16 + 8 * (fq & 1)) * 2;
            const bf16x8 b0 = *(const LAS bf16x8*)(lds + ub), b1 = *(const LAS bf16x8*)(lds + ub + 16 * 32);
            a0 = __builtin_amdgcn_mfma_f32_16x16x32_bf16(af, b0, a0, 0, 0, 0); a1 = __builtin_amdgcn_mfma_f32_16x16x32_bf16(af, b1, a1, 0, 0, 0);
        }
        LAS float* SL = (LAS float*)(lds + SSM_SLOC);
#pragma unroll
        for (int r = 0; r < 4; ++r) { SL[(16 * w + 4 * fq + r) * 32 + fr] = a0[r]; SL[(16 * w + 4 * fq + r) * 32 + 16 + fr] = a1[r]; }
    }
    __syncthreads();
    if (tid < 64) {
        const int p = tid; const float* a = wsp<float>(F, WS_A64) + (g * 64 + p) * 2; const float ar = a[0], ai = a[1];
        const LAS float* SL = (const LAS float*)(lds + SSM_SLOC); LAS bf16* SP = (LAS bf16*)(lds + SSM_SPREV);
        float sr = 0.f, si = 0.f;
#pragma unroll 4
        for (int n = 0; n < 32; ++n) { SP[n * 128 + p] = (bf16)f2bf(sr); SP[n * 128 + 64 + p] = (bf16)f2bf(si);
            const float lr_ = SL[p * 32 + n], li_ = SL[(64 + p) * 32 + n]; const float nr = ar * sr - ai * si + lr_, ni = ar * si + ai * sr + li_; sr = nr; si = ni; }
    }
    __syncthreads();
    f32x4 acc[8][2];
#pragma unroll
    for (int i = 0; i < 8; ++i) { acc[i][0] = (f32x4){0.f, 0.f, 0.f, 0.f}; acc[i][1] = acc[i][0]; }
#pragma unroll 1
    for (int j0 = 0; j0 < 32; ++j0) {
        const int ub = SSM_U + (((2 * j0 + (lane >> 5)) * 32 + fr) * 16 + 8 * (fq & 1)) * 2;
        const bf16x8 b0 = *(const LAS bf16x8*)(lds + ub), b1 = *(const LAS bf16x8*)(lds + ub + 16 * 32);
#pragma unroll
        for (int i = 0; i < 8; ++i) { const int t = w + 8 * i;
            if (2 * j0 <= t) { const int dd = t - 2 * j0 - (lane >> 5) + 1;
                const bf16x8 af = *(const LAS bf16x8*)(lds + SSM_MT + (dd * 256 + fr * 16 + 8 * (fq & 1)) * 2);
                acc[i][0] = __builtin_amdgcn_mfma_f32_16x16x32_bf16(af, b0, acc[i][0], 0, 0, 0); acc[i][1] = __builtin_amdgcn_mfma_f32_16x16x32_bf16(af, b1, acc[i][1], 0, 0, 0); } }
    }
    {
        const bf16* Rg = wsp<bf16>(F, WS_RTAB) + (size_t)g * 1024 * 128;
#pragma unroll
        for (int ks = 0; ks < 4; ++ks) {
            const int sb = SSM_SPREV + (fr * 128 + 32 * ks + 8 * fq) * 2;
            const bf16x8 b0 = *(const LAS bf16x8*)(lds + sb), b1 = *(const LAS bf16x8*)(lds + sb + 16 * 128 * 2);
#pragma unroll
            for (int i = 0; i < 8; ++i) { const int t = w + 8 * i; const bf16x8 af = *(const bf16x8*)(Rg + (size_t)(t * 16 + fr) * 128 + 32 * ks + 8 * fq);
                acc[i][0] = __builtin_amdgcn_mfma_f32_16x16x32_bf16(af, b0, acc[i][0], 0, 0, 0); acc[i][1] = __builtin_amdgcn_mfma_f32_16x16x32_bf16(af, b1, acc[i][1], 0, 0, 0); }
        }
    }
    {
        const f32x4 dsk = *(const f32x4*)(FIN(14) + g * 16 + 4 * fq); bf16* YG = wsp<bf16>(F, WS_YG);
#pragma unroll
        for (int i = 0; i < 8; ++i) { const int t = w + 8 * i;
#pragma unroll
            for (int ng = 0; ng < 2; ++ng) { const int n = 16 * ng + fr; const u32x2 uw = *(const LAS u32x2*)(lds + SSM_U + ((t * 32 + n) * 16 + 4 * fq) * 2);
                const f32x4 uv = (f32x4){bflo(uw.x), bfhi(uw.x), bflo(uw.y), bfhi(uw.y)}; f32x4 y = acc[i][ng] + dsk * uv;
#pragma unroll
                for (int r = 0; r < 4; ++r) { const float v = y[r]; y[r] = v * sigm(1.5957691216057308f * (v + 0.044715f * v * v * v)); }
                u32x2 o; o.x = pk2(y[0], y[1]); o.y = pk2(y[2], y[3]);
                *(u32x2*)(YG + ((size_t)(b * SEQ + n * 64 + t)) * 512 + g * 16 + 4 * fq) = o; } }
    }
    __syncthreads();
}

constexpr int RT_SEL = LDSCTL_OFF + 8192;
__device__ __forceinline__ void router_phase(Frame& F) {
    LAS unsigned char* lds = F.lds; const int tid = F.tid, lane = F.lane, w = F.wave;
    {   const float* W = FIN(19); const float* gff = FIN(18);
        for (int q = tid; q < 8192; q += 512) { const int k = q >> 3, c4 = q & 7; const f32x4 wv = *(const f32x4*)(W + (size_t)k * 32 + c4 * 4); const float g = gff[k];
#pragma unroll
            for (int i = 0; i < 4; ++i) { const int e = 4 * c4 + i; const float v = wv[i] * g; const unsigned hi = f2bf(v); const unsigned lo = f2bf(v - bflo(hi));
                const int addr = e * 2048 + (((k >> 3) ^ (e & 15)) << 4) + (k & 7) * 2;
                *(LAS bf16*)(lds + addr) = (bf16)hi; *(LAS bf16*)(lds + 65536 + addr) = (bf16)lo; } } }
    LAS int* hist = (LAS int*)(lds + RT_SEL + 2048); LAS int* base = hist + 32; LAS int* rec = (LAS int*)(lds + RT_SEL);
    if (tid < 32) hist[tid] = 0;
    __syncthreads();
    const float* X2 = wsp<float>(F, WS_X2); bf16* H2 = wsp<bf16>(F, WS_XN);
    const int fr = lane & 15, fq = lane >> 4;
    for (int tb = F.bx; tb < NTOK / 64; tb += F.G) {
        const int tok0 = tb * 64 + w * 8;
        const float* xr = X2 + (size_t)(tok0 + (fr & 7)) * DM + 8 * fq;
        f32x4 acc0 = (f32x4){0.f, 0.f, 0.f, 0.f}, acc1 = acc0; float ss = 0.f;
#pragma unroll 4
        for (int s = 0; s < 32; ++s) {
            const f32x4 x0 = *(const f32x4*)(xr + 32 * s), x1 = *(const f32x4*)(xr + 32 * s + 4);
            ss += (x0[0] * x0[0] + x0[1] * x0[1]) + (x0[2] * x0[2] + x0[3] * x0[3]) + (x1[0] * x1[0] + x1[1] * x1[1]) + (x1[2] * x1[2] + x1[3] * x1[3]);
            unsigned h[8], l[8];
#pragma unroll
            for (int i = 0; i < 4; ++i) { h[i] = f2bf(x0[i]); l[i] = f2bf(x0[i] - bflo(h[i])); h[4 + i] = f2bf(x1[i]); l[4 + i] = f2bf(x1[i] - bflo(h[4 + i])); }
            u32x4 ah, al; ah.x = h[0] | (h[1] << 16); ah.y = h[2] | (h[3] << 16); ah.z = h[4] | (h[5] << 16); ah.w = h[6] | (h[7] << 16);
            al.x = l[0] | (l[1] << 16); al.y = l[2] | (l[3] << 16); al.z = l[4] | (l[5] << 16); al.w = l[6] | (l[7] << 16);
            const bf16x8 ahi = __builtin_bit_cast(bf16x8, ah), alo = __builtin_bit_cast(bf16x8, al);
            const int boff = fr * 2048 + (((4 * s + fq) ^ fr) << 4);
            const bf16x8 bh0 = *(const LAS bf16x8*)(lds + boff), bh1 = *(const LAS bf16x8*)(lds + boff + 16 * 2048);
            const bf16x8 bl0 = *(const LAS bf16x8*)(lds + 65536 + boff), bl1 = *(const LAS bf16x8*)(lds + 65536 + boff + 16 * 2048);
            acc0 = __builtin_amdgcn_mfma_f32_16x16x32_bf16(ahi, bh0, acc0, 0, 0, 0); acc0 = __builtin_amdgcn_mfma_f32_16x16x32_bf16(alo, bh0, acc0, 0, 0, 0); acc0 = __builtin_amdgcn_mfma_f32_16x16x32_bf16(ahi, bl0, acc0, 0, 0, 0);
            acc1 = __builtin_amdgcn_mfma_f32_16x16x32_bf16(ahi, bh1, acc1, 0, 0, 0); acc1 = __builtin_amdgcn_mfma_f32_16x16x32_bf16(alo, bh1, acc1, 0, 0, 0); acc1 = __builtin_amdgcn_mfma_f32_16x16x32_bf16(ahi, bl1, acc1, 0, 0, 0);
        }
        ss += __shfl_xor(ss, 16); ss += __shfl_xor(ss, 32);
        const float rs = rsqrtf(ss * (1.f / DM) + EPS);
        const float b0 = FIN(20)[fr], b1 = FIN(20)[16 + fr];
        float my_v[4], sv0[4], den[4]; int my_e[4];
#pragma unroll
        for (int r = 0; r < 4; ++r) {
            const float rt = __shfl(rs, (4 * fq + r) & 7);
            float v0 = acc0[r] * rt + b0, v1 = acc1[r] * rt + b1; my_v[r] = 0.f; my_e[r] = 0; den[r] = 0.f; sv0[r] = 0.f;
#pragma unroll
            for (int q = 0; q < 4; ++q) {
                float bv; int bi; if (v0 >= v1) { bv = v0; bi = fr; } else { bv = v1; bi = 16 + fr; }
#pragma unroll
                for (int o = 1; o < 16; o <<= 1) { const float ov = __shfl_xor(bv, o); const int oi = __shfl_xor(bi, o); if (ov > bv || (ov == bv && oi < bi)) { bv = ov; bi = oi; } }
                if (q == 0) sv0[r] = bv;
                den[r] += __expf(bv - sv0[r]);
                if (fr == q) { my_v[r] = bv; my_e[r] = bi; }
                if (bi == fr) v0 = -INFINITY; if (bi == 16 + fr) v1 = -INFINITY;
            }
        }
        if (fq < 2 && fr < 4) {
#pragma unroll
            for (int r = 0; r < 4; ++r) { const int tl = w * 8 + 4 * fq + r, tok = tb * 64 + tl; const int e = my_e[r];
                const int rank = __hip_atomic_fetch_add(hist + e, 1, __ATOMIC_RELAXED, __HIP_MEMORY_SCOPE_WORKGROUP);
                rec[tl * 4 + fr] = (e << 16) | rank; wsp<float>(F, WS_TOPW)[tok * 4 + fr] = __expf(my_v[r] - sv0[r]) / den[r]; }
        }
#pragma unroll 2
        for (int tt = 0; tt < 8; ++tt) { const float rt = __shfl(rs, tt); const int tok = tok0 + tt;
#pragma unroll
            for (int j = 0; j < 4; ++j) { const f32x4 x = *((const f32x4*)(X2 + (size_t)tok * DM) + lane + 64 * j); const f32x4 g = *((const f32x4*)FIN(18) + lane + 64 * j);
                u32x2 o; o.x = pk2(x[0] * rt * g[0], x[1] * rt * g[1]); o.y = pk2(x[2] * rt * g[2], x[3] * rt * g[3]); *((u32x2*)(H2 + (size_t)tok * DM) + lane + 64 * j) = o; } }
        __syncthreads();
        if (tid < 32) { base[tid] = (int)atomicAdd((unsigned*)(F.ctl + CW_CNT + tid), (unsigned)hist[tid]); }
        __syncthreads();
        if (tid < 256) { const int rc = rec[tid], e = rc >> 16, rank = rc & 0xffff; wsp<int>(F, WS_LIST)[e * CAP + base[e] + rank] = (tb * 64 + (tid >> 2)) * 4 + (tid & 3); }
        __syncthreads();
        if (tid < 32) hist[tid] = 0;
        __syncthreads();
    }
}

__device__ __forceinline__ void combine_phase(Frame& F) {
    const int lane = F.lane, gw = F.bx * NWAVES + F.wave, NGW = F.G * NWAVES;
    const float* X2 = wsp<float>(F, WS_X2); const bf16* YS = wsp<bf16>(F, WS_YS); const float* TW = wsp<float>(F, WS_TOPW); bf16* H3 = wsp<bf16>(F, WS_XN);
    for (int tok = gw; tok < NTOK; tok += NGW) {
        const f32x4 tw = *(const f32x4*)(TW + tok * 4);
        f32x4 v[4]; float s = 0.f;
#pragma unroll
        for (int j = 0; j < 4; ++j) { v[j] = *((const f32x4*)(X2 + (size_t)tok * DM) + lane + 64 * j);
#pragma unroll
            for (int k = 0; k < 4; ++k) { const u32x2 yw = *((const u32x2*)(YS + ((size_t)tok * 4 + k) * DM) + lane + 64 * j); const float wk = tw[k];
                v[j].x += wk * bflo(yw.x); v[j].y += wk * bfhi(yw.x); v[j].z += wk * bflo(yw.y); v[j].w += wk * bfhi(yw.y); }
            s += (v[j].x * v[j].x + v[j].y * v[j].y) + (v[j].z * v[j].z + v[j].w * v[j].w);
            *((f32x4*)(F.out + (size_t)tok * DM) + lane + 64 * j) = v[j]; }
        const float r = rsqrtf(wave_sum(s) * (1.f / DM) + EPS);
#pragma unroll
        for (int j = 0; j < 4; ++j) { const f32x4 g = *((const f32x4*)FIN(25) + lane + 64 * j); u32x2 o; o.x = pk2(v[j].x * r * g.x, v[j].y * r * g.y); o.y = pk2(v[j].z * r * g.z, v[j].w * r * g.w);
            *((u32x2*)(H3 + (size_t)tok * DM) + lane + 64 * j) = o; }
    }
}
constexpr int NPHASE = 11;
constexpr int MOE_TST = LDSCTL_OFF + 4096;
struct Args { const float* in[29]; float* out; unsigned char* ws; int ph_lo, ph_hi; };
__global__ void __launch_bounds__(NWAVES * 64, 2) mega_fwd(Args args) {
    extern __shared__ __attribute__((aligned(16))) unsigned char lds_raw[];
    Frame F;
    F.lds = (LAS unsigned char*)lds_raw; F.tid = threadIdx.x; F.lane = F.tid & 63; F.wave = __builtin_amdgcn_readfirstlane(F.tid >> 6); F.G = gridDim.x; F.bx = blockIdx.x;
    F.ws = args.ws; F.out = args.out; F.ctl = (gu32*)(args.ws + WS_CTL);
    for (int u = F.tid; u < (LDS_BYTES - LDSCTL_OFF) / 4; u += NWAVES * 64) ((LAS unsigned*)(F.lds + LDSCTL_OFF))[u] = 0u;
    __syncthreads();
    if (F.tid < 29) ((LAS unsigned long long*)(F.lds + PTAB_OFF))[F.tid] = ((const unsigned long long*)__builtin_amdgcn_kernarg_segment_ptr())[F.tid];
    __syncthreads();
    volatile LAS unsigned* MISC = (volatile LAS unsigned*)(F.lds + MISC_OFF);
    XcdBarrier bar = xcd_barrier_post((unsigned*)(F.ctl + CW_BAR), MISC + 8);
    const int lo = args.ph_lo, hi = args.ph_hi;
#ifndef PH_MASK
#define PH_MASK 0xffff
#endif
#define IN_(k) (((PH_MASK >> (k)) & 1) && lo <= (k) && (k) < hi)
#define SEAM(k) do { if (IN_(k) && IN_((k) + 1)) xcd_barrier(bar); } while (0)
    LAS int* tst = (LAS int*)(F.lds + MOE_TST); LAS int* ecnt = tst + 33;

    if (IN_(0)) { p0_prologue(F); } SEAM(0);
    if (IN_(1)) {
        { pg8::Gemm g{wsp<bf16>(F, WS_XN), wsp<bf16>(F, WS_WIN), 1024}; pg8::StaticOrder S; S.init(NTOK, INC, F.G, F.bx);
          epi::EpiInProj E{wsp<bf16>(F, WS_QH), wsp<bf16>(F, WS_KH), wsp<bf16>(F, WS_VT), wsp<bf16>(F, WS_U), wsp<bf16>(F, WS_SGA), wsp<bf16>(F, WS_SGS), FIN(4), FIN(5)};
          pg8::gemm_phase<epi::EpiInProj, pg8::StaticOrder, false>(F.lds, g, S, E); }
        { pg8::Gemm g{wsp<bf16>(F, WS_PBF), wsp<bf16>(F, WS_WPP), 256}; pg8::StaticOrder S; S.init(NTOK, DM, F.G, F.bx);
          epi::EpiPle E{wsp<bf16>(F, WS_PP), wsp<float>(F, WS_PSS)};
          pg8::gemm_phase<epi::EpiPle, pg8::StaticOrder, false>(F.lds, g, S, E); }
    } SEAM(1);
    if (IN_(2)) {
        for (int it = F.bx; it < NBATCH * 32; it += F.G) ssm_item(F, it >> 5, it & 31);
        const int gw = F.bx * NWAVES + F.wave, NGW = F.G * NWAVES;
        for (int it = gw; it < 64 * 32; it += NGW) { const int bh = it >> 5, q = it & 31;
            attn_tile<true>(wsp<bf16>(F, WS_QH), wsp<bf16>(F, WS_KH), wsp<bf16>(F, WS_VT), wsp<bf16>(F, WS_O), bh, q, F.lane);
            attn_tile<true>(wsp<bf16>(F, WS_QH), wsp<bf16>(F, WS_KH), wsp<bf16>(F, WS_VT), wsp<bf16>(F, WS_O), bh, 63 - q, F.lane); }
    } SEAM(2);
    if (IN_(3)) { pg8::Gemm g{wsp<bf16>(F, WS_O), wsp<bf16>(F, WS_WAB), 512}; pg8::StaticOrder S; S.init(NTOK, DM, F.G, F.bx);
        epi::EpiT1 E{wsp<bf16>(F, WS_SGA), wsp<bf16>(F, WS_T1)}; pg8::gemm_phase<epi::EpiT1, pg8::StaticOrder, false>(F.lds, g, S, E); } SEAM(3);
    if (IN_(4)) { pg8::Gemm g{wsp<bf16>(F, WS_YG), wsp<bf16>(F, WS_WGLU), 512}; pg8::StaticOrder S; S.init(NTOK, 2048, F.G, F.bx);
        epi::EpiGlu E{wsp<bf16>(F, WS_T1), wsp<bf16>(F, WS_SGS), FIN(16), wsp<bf16>(F, WS_MIX)}; pg8::gemm_phase<epi::EpiGlu, pg8::StaticOrder, false>(F.lds, g, S, E); } SEAM(4);
    if (IN_(5)) { pg8::Gemm g{wsp<bf16>(F, WS_MIX), wsp<bf16>(F, WS_WOUT), 1024}; pg8::StaticOrder S; S.init(NTOK, DM, F.G, F.bx);
        epi::EpiX2 E{FIN(0), wsp<float>(F, WS_X2)}; pg8::gemm_phase<epi::EpiX2, pg8::StaticOrder, false>(F.lds, g, S, E); } SEAM(5);
    if (IN_(6)) { router_phase(F); } SEAM(6);
    if (IN_(7) || IN_(8)) {
        if (F.tid == 0) { int a = 0; for (int e = 0; e < NE; ++e) { const int c = (int)__hip_atomic_load(F.ctl + CW_CNT + e, RLX_AGENT); ecnt[e] = c; tst[e] = a; a += (c + 255) >> 8; } tst[32] = a; }
        __syncthreads();
    }
    if (IN_(7)) { pg8::Gemm g{wsp<bf16>(F, WS_XN), wsp<bf16>(F, WS_WUP), 1024}; pg8::MoeOrder S{tst, ecnt, wsp<int>(F, WS_LIST), 8, F.bx, F.G, 2};
        epi::EpiUp E{FIN(22), wsp<bf16>(F, WS_ACT)}; pg8::gemm_phase<epi::EpiUp, pg8::MoeOrder, true>(F.lds, g, S, E); } SEAM(7);
    if (IN_(8)) { pg8::Gemm g{wsp<bf16>(F, WS_ACT), wsp<bf16>(F, WS_WDN), 1024}; pg8::MoeOrder S{tst, ecnt, wsp<int>(F, WS_LIST), 4, F.bx, F.G, 0};
        epi::EpiDown E{FIN(24), wsp<int>(F, WS_LIST), wsp<bf16>(F, WS_YS)}; pg8::gemm_phase<epi::EpiDown, pg8::MoeOrder, false>(F.lds, g, S, E); } SEAM(8);
    if (IN_(9)) { combine_phase(F); } SEAM(9);
    if (IN_(10)) { pg8::Gemm g{wsp<bf16>(F, WS_XN), wsp<bf16>(F, WS_WPG), 1024}; pg8::StaticOrder S; S.init(NTOK, DM, F.G, F.bx);
        epi::EpiFinal E{F.out, wsp<bf16>(F, WS_PP), wsp<float>(F, WS_PSS), FIN(28)}; pg8::gemm_phase<epi::EpiFinal, pg8::StaticOrder, false>(F.lds, g, S, E); }
#undef IN_
#undef SEAM
}

__global__ void g_bf2f(const bf16* src, float* dst, size_t n) { const size_t i = (size_t)blockIdx.x * blockDim.x + threadIdx.x; if (i < n) dst[i] = bflo((unsigned)src[i]); }
__global__ void g_proj(const bf16* QH, const bf16* KH, const bf16* VT, const bf16* U, const bf16* SGA, const bf16* SGS, float* PROJ, int mask) {
    const size_t i = (size_t)blockIdx.x * blockDim.x + threadIdx.x; if (i >= (size_t)NTOK * INC) return;
    const int t = (int)(i >> 12), c = (int)(i & 4095), b = t >> 11, s = t & 2047; float v;
    { const int sec = c < 512 ? 0 : c < 1024 ? 1 : c < 1536 ? 2 : c < 2048 ? 3 : c < 3072 ? 4 : 5; if (!((mask >> sec) & 1)) return; }
    if (c < 512) { const int h = c >> 6, d = c & 63; v = bflo(QH[((size_t)(b * 8 + h) * SEQ + s) * 64 + d]) * (1.f / LOG2E); }
    else if (c < 1024) { const int cc = c - 512, h = cc >> 6, d = cc & 63; v = bflo(KH[((size_t)(b * 8 + h) * SEQ + s) * 64 + d]); }
    else if (c < 1536) { const int cc = c - 1024; v = bflo(VT[((size_t)b * 512 + cc) * SEQ + s]); }
    else if (c < 2048) v = bflo(U[(size_t)t * 512 + c - 1536]);
    else if (c < 3072) v = bflo(SGA[(size_t)t * 1024 + c - 2048]);
    else v = bflo(SGS[(size_t)t * 1024 + c - 3072]);
    PROJ[i] = v;
}
}

#ifndef HYB
#define HYB 0
#endif
extern "C" void kernel_launch(void* const* d_in, const int* in_sizes, int n_in, void* d_out, int out_size, void* d_ws, size_t ws_size, hipStream_t stream) {
    using namespace mk;
    static int grid = 0;
    if (grid == 0) {
        int dev = 0, cus = 0, per_cu = 0;
        if (hipGetDevice(&dev) != hipSuccess || hipDeviceGetAttribute(&cus, hipDeviceAttributeMultiprocessorCount, dev) != hipSuccess) { fprintf(stderr, "kernel_launch: device query failed\n"); grid = -1; return; }
        if (hipFuncSetAttribute((const void*)mega_fwd, hipFuncAttributeMaxDynamicSharedMemorySize, LDS_BYTES) != hipSuccess) { fprintf(stderr, "kernel_launch: hipFuncSetAttribute failed\n"); grid = -1; return; }
        if (hipOccupancyMaxActiveBlocksPerMultiprocessor(&per_cu, (const void*)mega_fwd, NWAVES * 64, LDS_BYTES) != hipSuccess || per_cu < 1) fprintf(stderr, "kernel_launch: occupancy query says %d\n", per_cu);
        (void)hipGetLastError();
        grid = cus;
        if (ws_size < WS_END) { fprintf(stderr, "kernel_launch: workspace too small\n"); grid = -1; return; }
    }
    if (grid < 0) return;
    hipMemsetAsync((char*)d_ws + WS_CTL, 0, CTL_ZERO_BYTES, stream);
    Args a{};
    for (int i = 0; i < 29; ++i) a.in[i] = (const float*)d_in[i];
    a.out = (float*)d_out; a.ws = (unsigned char*)d_ws;
    const int hyb_hi[6] = {NPHASE, 2, 3, 6, 10, NPHASE};
#ifdef PROBE_PH
    a.ph_lo = 0; a.ph_hi = PROBE_PH + 1;
    hipLaunchKernelGGL(mega_fwd, dim3(grid), dim3(NWAVES * 64), LDS_BYTES, stream, a);
    hipMemsetAsync((char*)d_ws + WS_CTL + CW_BAR * 4, 0, XCD_BAR_WORDS * 4, stream);
    if (PROBE_PH == 6) hipMemsetAsync((char*)d_ws + WS_CTL + CW_CNT * 4, 0, 256, stream);
    a.ph_lo = PROBE_PH; a.ph_hi = NPHASE;
    hipLaunchKernelGGL(mega_fwd, dim3(grid), dim3(NWAVES * 64), LDS_BYTES, stream, a);
#else
    a.ph_lo = 0; a.ph_hi = hyb_hi[HYB];
    hipLaunchKernelGGL(mega_fwd, dim3(grid), dim3(NWAVES * 64), LDS_BYTES, stream, a);
#endif
#if HYB != 0
    {
        unsigned char* ws = (unsigned char*)d_ws; float* nPP = (float*)(ws + 720 * MiB); float* nPROJ = (float*)(ws + 64 * MiB);
#ifndef GLUEMASK
#define GLUEMASK 0x7f
#endif
        int gmask = (HYB == 2) ? 0x30 : (GLUEMASK & 0x3f); const int ppg = (GLUEMASK >> 6) & 1;
        if (ppg) hipLaunchKernelGGL(g_bf2f, dim3(NTOK * DM / 256), dim3(256), 0, stream, (const bf16*)(ws + WS_PP), nPP, (size_t)NTOK * DM);
        if (HYB == 1 && gmask != 0x3f) {
            hipLaunchKernelGGL(nv::k_rmsnorm, dim3(NTOK / 4), dim3(256), 0, stream, (const float*)d_in[0], (const float*)d_in[2], (float*)ws, NTOK);
            nv::gemm(stream, (float*)ws, DM, (const float*)d_in[3], INC, nPROJ, INC, NTOK, INC, DM, nullptr, nullptr);
            hipLaunchKernelGGL(nv::k_qknorm, dim3(NTOK * 16 / 256), dim3(256), 0, stream, nPROJ, (const float*)d_in[4], (const float*)d_in[5]);
        }
        if (HYB == 1 || HYB == 2)
            hipLaunchKernelGGL(g_proj, dim3(NTOK * INC / 256), dim3(256), 0, stream, (const bf16*)(ws + WS_QH), (const bf16*)(ws + WS_KH), (const bf16*)(ws + WS_VT), (const bf16*)(ws + WS_U), (const bf16*)(ws + WS_SGA), (const bf16*)(ws + WS_SGS), nPROJ, gmask);
        if (HYB == 2) {
            hipLaunchKernelGGL(g_bf2f, dim3(NTOK * 512 / 256), dim3(256), 0, stream, (const bf16*)(ws + WS_O), (float*)(ws + 320 * MiB), (size_t)NTOK * 512);
            hipLaunchKernelGGL(g_bf2f, dim3(NTOK * 512 / 256), dim3(256), 0, stream, (const bf16*)(ws + WS_YG), (float*)(ws + 352 * MiB), (size_t)NTOK * 512);
        }
        if (HYB == 3) hipMemcpyAsync(ws + 640 * MiB, ws + WS_X2, (size_t)NTOK * DM * 4, hipMemcpyDeviceToDevice, stream);
        nv::forward(d_in, (float*)d_out, ws, stream, HYB, (HYB == 1 && (gmask & 0x30) != 0x30) ? 0 : 1, ppg, (const float*)(ws + 640 * MiB));
    }
#endif
}
```

```cpp
#define HYB 0
#define GLUEMASK 0x7f
#include <hip/hip_runtime.h>
#include <cstdint>
#include <cstdio>

namespace nv {
constexpr int NTOK = 16384, DM = 1024, SEQ = 2048, NB = 8, INC = 4096, NE = 32, CAP = 16384;
constexpr float EPS = 1e-6f;

__device__ __forceinline__ float sigmoidf_(float x) { return 1.f / (1.f + __expf(-x)); }
__device__ __forceinline__ float wave_sum(float v) {
#pragma unroll
    for (int o = 1; o < 64; o <<= 1) v += __shfl_xor(v, o);
    return v;
}

__global__ void k_rmsnorm(const float* x, const float* g, float* out, int rows) {
    const int lane = threadIdx.x & 63, w = (blockIdx.x * blockDim.x + threadIdx.x) >> 6;
    if (w >= rows) return;
    const float4* xr = (const float4*)(x + (size_t)w * DM);
    float4 v[4]; float s = 0.f;
#pragma unroll
    for (int j = 0; j < 4; ++j) { v[j] = xr[lane + 64 * j]; s += v[j].x * v[j].x + v[j].y * v[j].y + v[j].z * v[j].z + v[j].w * v[j].w; }
    const float r = rsqrtf(wave_sum(s) * (1.f / DM) + EPS);
    float4* o = (float4*)(out + (size_t)w * DM);
#pragma unroll
    for (int j = 0; j < 4; ++j) { const float4 gg = ((const float4*)g)[lane + 64 * j]; o[lane + 64 * j] = make_float4(v[j].x * r * gg.x, v[j].y * r * gg.y, v[j].z * r * gg.z, v[j].w * r * gg.w); }
}

struct GemmP {
    const float* A; int lda; const float* B; int ldb; float* C; int ldc; int M, N, K;
    const float* bias; const float* resid; const int* list; const int* cnt; int ashift; size_t bstride; int biasstride; int dual;
};
__global__ void __launch_bounds__(256) k_gemm(GemmP p) {
    __shared__ float As[16][68], Bs[16][64], Bs2[16][64];
    const int tid = threadIdx.x, ty = tid >> 4, tx = tid & 15, e = blockIdx.z;
    int M = p.M; const int* list = nullptr;
    const float* B = p.B + (size_t)e * p.bstride; const float* bias = p.bias ? p.bias + (size_t)e * p.biasstride : nullptr;
    if (p.list) { M = p.cnt[e]; list = p.list + (size_t)e * CAP; }
    const int m0 = blockIdx.y * 64, n0 = blockIdx.x * 64;
    if (m0 >= M) return;
    const int lr = tid >> 2, lk = (tid & 3) * 4;
    int arow = m0 + lr; bool avalid = arow < M;
    if (list && avalid) arow = list[arow] >> p.ashift;
    const float* Ap = p.A + (size_t)arow * p.lda + lk;
    const int bk = tid >> 4, bn = (tid & 15) * 4;
    float acc[4][4] = {}, acc2[4][4] = {};
    for (int k0 = 0; k0 < p.K; k0 += 16) {
        float4 a = avalid ? *(const float4*)(Ap + k0) : make_float4(0, 0, 0, 0);
        As[lk + 0][lr] = a.x; As[lk + 1][lr] = a.y; As[lk + 2][lr] = a.z; As[lk + 3][lr] = a.w;
        *(float4*)&Bs[bk][bn] = *(const float4*)(B + (size_t)(k0 + bk) * p.ldb + n0 + bn);
        if (p.dual) *(float4*)&Bs2[bk][bn] = *(const float4*)(B + (size_t)(k0 + bk) * p.ldb + n0 + bn + p.N);
        __syncthreads();
#pragma unroll
        for (int k = 0; k < 16; ++k) {
            const float4 av = *(const float4*)&As[k][ty * 4]; const float4 bv = *(const float4*)&Bs[k][tx * 4];
            const float aa[4] = {av.x, av.y, av.z, av.w}, bb[4] = {bv.x, bv.y, bv.z, bv.w};
#pragma unroll
            for (int i = 0; i < 4; ++i)
#pragma unroll
                for (int j = 0; j < 4; ++j) acc[i][j] += aa[i] * bb[j];
            if (p.dual) { const float4 cv = *(const float4*)&Bs2[k][tx * 4]; const float cc[4] = {cv.x, cv.y, cv.z, cv.w};
#pragma unroll
                for (int i = 0; i < 4; ++i)
#pragma unroll
                    for (int j = 0; j < 4; ++j) acc2[i][j] += aa[i] * cc[j]; }
        }
        __syncthreads();
    }
#pragma unroll
    for (int i = 0; i < 4; ++i) {
        int r = m0 + ty * 4 + i; if (r >= M) continue;
        const int crow = list ? list[r] : r;
        float o[4];
#pragma unroll
        for (int j = 0; j < 4; ++j) {
            const int c = n0 + tx * 4 + j; float v = acc[i][j] + (bias ? bias[c] : 0.f);
            if (p.dual) { float up = acc2[i][j] + bias[c + p.N]; float g = fminf(v, 7.f); up = fminf(fmaxf(up, -7.f), 7.f); v = (up + 1.f) * g * sigmoidf_(1.702f * g); }
            if (p.resid) v += p.resid[(size_t)crow * p.ldc + c];
            o[j] = v;
        }
        *(float4*)(p.C + (size_t)crow * p.ldc + n0 + tx * 4) = make_float4(o[0], o[1], o[2], o[3]);
    }
}

__global__ void k_qknorm(float* proj, const float* gq, const float* gk) {
    const int i = blockIdx.x * blockDim.x + threadIdx.x;
    if (i >= NTOK * 16) return;
    const int t = i >> 4, which = (i >> 3) & 1, h = i & 7;
    float* p = proj + (size_t)t * INC + which * 512 + h * 64; const float* g = which ? gk : gq;
    float s = 0.f; for (int d = 0; d < 64; ++d) s += p[d] * p[d];
    const float r = rsqrtf(s * (1.f / 64.f) + EPS) * (which ? 1.f : 0.125f);
    for (int d = 0; d < 64; ++d) p[d] = p[d] * r * g[d];
}

__global__ void __launch_bounds__(64) k_attn(const float* __restrict__ proj, float* __restrict__ o) {
    const int lane = threadIdx.x, tb = blockIdx.x % (SEQ / 64), bh = blockIdx.x / (SEQ / 64), b = bh >> 3, h = bh & 7;
    const int t = tb * 64 + lane;
    const float* base = proj + (size_t)b * SEQ * INC + h * 64;
    float q[64], acc[64];
#pragma unroll
    for (int d = 0; d < 64; ++d) { q[d] = base[(size_t)t * INC + d]; acc[d] = 0.f; }
    float R = 0.f;
    for (int s = tb * 64 + 62; s >= 0; --s) {
        const float* kr = base + (size_t)s * INC + 512; const float* vr = base + (size_t)s * INC + 1024;
        float z = 0.f;
#pragma unroll
        for (int d = 0; d < 64; ++d) z += q[d] * kr[d];
        if (s < t) {
            const float sp = fmaxf(z, 0.f) + log1pf(__expf(-fabsf(z)));
            const float w = __expf(z - sp + R);
#pragma unroll
            for (int d = 0; d < 64; ++d) acc[d] += w * vr[d];
            R -= sp;
        }
    }
    float* op = o + ((size_t)b * SEQ + t) * 512 + h * 64;
#pragma unroll
    for (int d = 0; d < 64; ++d) op[d] = acc[d];
}

__global__ void __launch_bounds__(64) k_ssm(const float* __restrict__ proj, const float* a_re, const float* a_im, const float* log_dt, const float* b_re, const float* b_im,
                                            const float* c_re, const float* c_im, const float* d_skip, float* __restrict__ yg) {
    const int p = threadIdx.x, b = blockIdx.x >> 5, g = blockIdx.x & 31;
    const float lr = a_re[g * 64 + p], li = a_im[g * 64 + p], dt = expf(log_dt[g]);
    const float mag = expf(lr * dt), ar = mag * cosf(li * dt), ai = mag * sinf(li * dt);
    const float den = lr * lr + li * li, nr = ar - 1.f, ni = ai, fr = (nr * lr + ni * li) / den, fi = (ni * lr - nr * li) / den;
    float bbr[16], bbi[16], cr[16], ci[16];
#pragma unroll
    for (int c = 0; c < 16; ++c) { const float br = b_re[(g * 64 + p) * 16 + c], bi = b_im[(g * 64 + p) * 16 + c]; bbr[c] = fr * br - fi * bi; bbi[c] = fr * bi + fi * br;
        cr[c] = c_re[(g * 16 + c) * 64 + p]; ci[c] = c_im[(g * 16 + c) * 64 + p]; }
    const float dsk = p < 16 ? d_skip[g * 16 + p] : 0.f;
    float hr = 0.f, hi = 0.f;
    for (int t = 0; t < SEQ; ++t) {
        const float* up = proj + ((size_t)b * SEQ + t) * INC + 1536 + g * 16;
        float u[16], xr = 0.f, xi = 0.f;
#pragma unroll
        for (int c = 0; c < 16; ++c) { u[c] = up[c]; xr += bbr[c] * u[c]; xi += bbi[c] * u[c]; }
        const float nhr = ar * hr - ai * hi + xr, nhi = ar * hi + ai * hr + xi; hr = nhr; hi = nhi;
        float mine = 0.f, myu = 0.f;
#pragma unroll
        for (int c = 0; c < 16; ++c) { const float s = wave_sum(cr[c] * hr - ci[c] * hi); if (p == c) { mine = s; myu = u[c]; } }
        if (p < 16) { const float y = mine + dsk * myu; const float gl = 0.5f * y * (1.f + tanhf(0.7978845608028654f * (y + 0.044715f * y * y * y)));
            yg[((size_t)b * SEQ + t) * 512 + g * 16 + p] = gl; }
    }
}

__global__ void k_mix(const float* __restrict__ proj, const float* __restrict__ ab, const float* __restrict__ zg, float* __restrict__ mixed, int gsig) {
    const size_t i = (size_t)blockIdx.x * blockDim.x + threadIdx.x; if (i >= (size_t)NTOK * DM) return;
    const size_t t = i >> 10; const int c = i & 1023;
    const float ga = proj[t * INC + 2048 + c], gs = proj[t * INC + 3072 + c];
    const float z1 = zg[t * 2048 + c], z2 = zg[t * 2048 + 1024 + c];
    mixed[i] = (gsig ? ga : sigmoidf_(ga)) * ab[i] + (gsig ? gs : sigmoidf_(gs)) * (z1 * sigmoidf_(z2));
}

__global__ void k_router(const float* __restrict__ h2, const float* __restrict__ wr, const float* __restrict__ br, int* cnt, int* list, float* topw) {
    const int lane = threadIdx.x & 63, t = (blockIdx.x * blockDim.x + threadIdx.x) >> 6; if (t >= NTOK) return;
    const int e = lane & 31, kh = lane >> 5; const float* hp = h2 + (size_t)t * DM + kh * 512; const float* wp = wr + (size_t)kh * 512 * 32 + e;
    float s = 0.f; for (int k = 0; k < 512; ++k) s += hp[k] * wp[(size_t)k * 32];
    s += __shfl_xor(s, 32); s += br[e];
    float v = s; int sel[4]; float sv[4];
#pragma unroll
    for (int r = 0; r < 4; ++r) {
        float bv = v; int bi = e;
#pragma unroll
        for (int o = 1; o < 32; o <<= 1) { const float ov = __shfl_xor(bv, o); const int oi = __shfl_xor(bi, o); if (ov > bv || (ov == bv && oi < bi)) { bv = ov; bi = oi; } }
        sel[r] = bi; sv[r] = bv; if (e == bi) v = -INFINITY;
    }
    const float m = sv[0]; float ex[4], den = 0.f;
#pragma unroll
    for (int r = 0; r < 4; ++r) { ex[r] = __expf(sv[r] - m); den += ex[r]; }
    if (lane < 4) { const int r = lane; const int ee = sel[r]; const int pos = atomicAdd(&cnt[ee], 1); list[ee * CAP + pos] = t * 4 + r; topw[t * 4 + r] = ex[r] / den; }
}

__global__ void k_combine(const float* __restrict__ x2, const float* __restrict__ y, const float* __restrict__ topw, float* __restrict__ x3) {
    const size_t i = (size_t)blockIdx.x * blockDim.x + threadIdx.x; if (i >= (size_t)NTOK * DM) return;
    const size_t t = i >> 10; const int c = i & 1023; float v = x2[i];
#pragma unroll
    for (int k = 0; k < 4; ++k) v += topw[t * 4 + k] * y[(t * 4 + k) * DM + c];
    x3[i] = v;
}
__global__ void k_final(const float* __restrict__ x3, const float* __restrict__ gate, const float* __restrict__ ple, float* __restrict__ out) {
    const size_t i = (size_t)blockIdx.x * blockDim.x + threadIdx.x; if (i >= (size_t)NTOK * DM) return;
    out[i] = x3[i] + sigmoidf_(gate[i]) * ple[i];
}

inline void gemm(hipStream_t st, const float* A, int lda, const float* B, int ldb, float* C, int ldc, int M, int N, int K, const float* bias, const float* resid) {
    GemmP p{}; p.A = A; p.lda = lda; p.B = B; p.ldb = ldb; p.C = C; p.ldc = ldc; p.M = M; p.N = N; p.K = K; p.bias = bias; p.resid = resid;
    hipLaunchKernelGGL(k_gemm, dim3(N / 64, M / 64, 1), dim3(256), 0, st, p);
}


inline void forward(void* const* d_in, float* out, unsigned char* ws, hipStream_t st, int from = 0, int gsig = 0, int pp_given = 0, const float* x2p = nullptr) {
    const float* x = (const float*)d_in[0]; const float* pin = (const float*)d_in[1];
#define IN(i) ((const float*)d_in[i])
    constexpr size_t MiB = 1u << 20;
    float* H = (float*)(ws + 0 * MiB); float* PROJ = (float*)(ws + 64 * MiB); float* O = (float*)(ws + 320 * MiB); float* YG = (float*)(ws + 352 * MiB);
    float* AB = (float*)(ws + 384 * MiB); float* ZG = (float*)(ws + 448 * MiB); float* MIX = (float*)(ws + 576 * MiB); float* X2 = (float*)(ws + 640 * MiB);
    int* CNT = (int*)(ws + 704 * MiB); int* LIST = (int*)(ws + 705 * MiB); float* TOPW = (float*)(ws + 708 * MiB);
    float* ACT = (float*)(ws + 64 * MiB); float* Y = (float*)(ws + 320 * MiB); float* X3 = (float*)(ws + 576 * MiB); float* GATE = (float*)(ws + 64 * MiB); float* PP = (float*)(ws + 720 * MiB);
    const int EW = NTOK * DM / 256;
    if (from <= 0) {
        hipLaunchKernelGGL(k_rmsnorm, dim3(NTOK / 4), dim3(256), 0, st, x, IN(2), H, NTOK);
        gemm(st, H, DM, IN(3), INC, PROJ, INC, NTOK, INC, DM, nullptr, nullptr);
        hipLaunchKernelGGL(k_qknorm, dim3(NTOK * 16 / 256), dim3(256), 0, st, PROJ, IN(4), IN(5));
    }
    if (from <= 1) {
        hipLaunchKernelGGL(k_attn, dim3(NB * 8 * (SEQ / 64)), dim3(64), 0, st, PROJ, O);
        hipLaunchKernelGGL(k_ssm, dim3(NB * 32), dim3(64), 0, st, PROJ, IN(7), IN(8), IN(9), IN(10), IN(11), IN(12), IN(13), IN(14), YG);
    }
    if (from <= 2) {
        gemm(st, O, 512, IN(6), DM, AB, DM, NTOK, DM, 512, nullptr, nullptr);
        gemm(st, YG, 512, IN(15), 2048, ZG, 2048, NTOK, 2048, 512, IN(16), nullptr);
        hipLaunchKernelGGL(k_mix, dim3(EW), dim3(256), 0, st, PROJ, AB, ZG, MIX, gsig);
        gemm(st, MIX, DM, IN(17), DM, X2, DM, NTOK, DM, DM, nullptr, x);
    }
    if (from <= 3) {
        const float* X2r = (from == 3) ? x2p : X2;
        hipMemsetAsync(CNT, 0, 256, st);
        hipLaunchKernelGGL(k_rmsnorm, dim3(NTOK / 4), dim3(256), 0, st, X2r, IN(18), H, NTOK);
        hipLaunchKernelGGL(k_router, dim3(NTOK / 4), dim3(256), 0, st, H, IN(19), IN(20), CNT, LIST, TOPW);
        { GemmP p{}; p.A = H; p.lda = DM; p.B = IN(21); p.ldb = 2048; p.C = ACT; p.ldc = DM; p.M = 0; p.N = 1024; p.K = DM; p.bias = IN(22); p.list = LIST; p.cnt = CNT; p.ashift = 2;
          p.bstride = (size_t)1024 * 2048; p.biasstride = 2048; p.dual = 1;
          hipLaunchKernelGGL(k_gemm, dim3(1024 / 64, CAP / 64, NE), dim3(256), 0, st, p); }
        { GemmP p{}; p.A = ACT; p.lda = DM; p.B = IN(23); p.ldb = DM; p.C = Y; p.ldc = DM; p.M = 0; p.N = 1024; p.K = DM; p.bias = IN(24); p.list = LIST; p.cnt = CNT; p.ashift = 0;
          p.bstride = (size_t)1024 * 1024; p.biasstride = 1024; p.dual = 0;
          hipLaunchKernelGGL(k_gemm, dim3(1024 / 64, CAP / 64, NE), dim3(256), 0, st, p); }
        hipLaunchKernelGGL(k_combine, dim3(EW), dim3(256), 0, st, X2r, Y, TOPW, X3);
    }
    {
        const float* X3r = (from == 4) ? out : X3;
        hipLaunchKernelGGL(k_rmsnorm, dim3(NTOK / 4), dim3(256), 0, st, X3r, IN(25), H, NTOK);
        gemm(st, H, DM, IN(26), DM, GATE, DM, NTOK, DM, DM, nullptr, nullptr);
        if (!pp_given) gemm(st, pin, 256, IN(27), DM, PP, DM, NTOK, DM, 256, nullptr, nullptr);
        hipLaunchKernelGGL(k_rmsnorm, dim3(NTOK / 4), dim3(256), 0, st, PP, IN(28), PP, NTOK);
        hipLaunchKernelGGL(k_final, dim3(EW), dim3(256), 0, st, X3r, GATE, PP, out);
    }
#undef IN
}
}
#include <hip/hip_runtime.h>
#include <cstdint>
#include <cstdio>
namespace mk {
#define LAS __attribute__((address_space(3)))
#define GAS __attribute__((address_space(1)))
typedef unsigned short bf16;
typedef short bf16x8 __attribute__((ext_vector_type(8)));
typedef float f32x4 __attribute__((ext_vector_type(4)));
typedef float f32x16 __attribute__((ext_vector_type(16)));
typedef float f32x2 __attribute__((ext_vector_type(2)));
typedef unsigned u32x4 __attribute__((ext_vector_type(4)));
typedef unsigned u32x2 __attribute__((ext_vector_type(2)));
typedef GAS unsigned gu32;

constexpr int NTOK = 16384, DM = 1024, SEQ = 2048, NBATCH = 8, INC = 4096, NE = 32, CAP = 16384, NHEAD = 8, HD = 64;
constexpr float EPS = 1e-6f;
constexpr int MAXRT = 288;
constexpr size_t MiB = 1u << 20;
constexpr size_t WS_CTL = 0, CTL_ZERO_BYTES = 1 * MiB;
constexpr size_t WS_LIST = 1 * MiB, WS_TOPW = 3 * MiB, WS_PSS = 4 * MiB, WS_A64 = 5 * MiB, WS_MTAB = 6 * MiB, WS_PTAB = 8 * MiB, WS_RTAB = 16 * MiB;
constexpr size_t WS_WIN = 26 * MiB, WS_WAB = 34 * MiB, WS_WGLU = 35 * MiB, WS_WOUT = 37 * MiB, WS_WPG = 39 * MiB, WS_WPP = 41 * MiB, WS_WUP = 42 * MiB, WS_WDN = 170 * MiB;
constexpr size_t WS_XN = 234 * MiB, WS_PBF = 266 * MiB, WS_PP = 274 * MiB, WS_X2 = 306 * MiB;
constexpr size_t WS_QH = 370 * MiB, WS_KH = 386 * MiB, WS_VT = 402 * MiB, WS_U = 418 * MiB, WS_SGA = 434 * MiB, WS_SGS = 466 * MiB, WS_O = 498 * MiB, WS_YG = 514 * MiB, WS_T1 = 530 * MiB, WS_MIX = 562 * MiB;
constexpr size_t WS_ACT = 370 * MiB, WS_YS = 594 * MiB, WS_END = 722 * MiB;
constexpr int CW_TMO = 0, CW_BAR = 4096, CW_CNT = 8192;
constexpr int RING_BYTES = 131072, LDSCTL_OFF = RING_BYTES, MISC_OFF = LDSCTL_OFF + 320, LDS_BYTES = 147456;
constexpr int NWAVES = 8;

#define RLX_AGENT __ATOMIC_RELAXED, __HIP_MEMORY_SCOPE_AGENT
#define LDS_WAIT() asm volatile("s_waitcnt lgkmcnt(0)" ::: "memory")
#define VM_WAIT() asm volatile("s_waitcnt vmcnt(0)" ::: "memory")
typedef __bf16 hwbf16x2 __attribute__((ext_vector_type(2)));
__device__ __forceinline__ unsigned pk2(float lo, float hi) { const f32x2 v = {lo, hi}; return __builtin_bit_cast(unsigned, __builtin_convertvector(v, hwbf16x2)); }
__device__ __forceinline__ unsigned f2bf(float f) { return pk2(f, 0.f) & 0xffffu; }
__device__ __forceinline__ float bflo(unsigned w) { return __builtin_bit_cast(float, w << 16); }
__device__ __forceinline__ float bfhi(unsigned w) { return __builtin_bit_cast(float, w & 0xffff0000u); }
__device__ __forceinline__ float sigm(float x) { return __builtin_amdgcn_rcpf(1.f + __expf(-x)); }
__device__ __forceinline__ float wave_sum(float v) {
#pragma unroll
    for (int o = 1; o < 64; o <<= 1) v += __shfl_xor(v, o);
    return v;
}

#define XB_TMO      128
#define XB_XCNT(j)  (256  + 64 * (j))
#define XB_XSUB(j)  (1280 + 64 * (j))
#define XB_XGEN(j)  (2304 + 64 * (j))
#define XB_TOP      3328
#define XB_TOPGEN   3392
#define XCD_BAR_WORDS 3456
#define XB_SPIN_CAP (1u << 18)
__device__ __forceinline__ unsigned xb_ld(unsigned* p)              { return __hip_atomic_load(p, __ATOMIC_RELAXED, __HIP_MEMORY_SCOPE_AGENT); }
__device__ __forceinline__ unsigned xb_add(unsigned* p, unsigned v) { return __hip_atomic_fetch_add(p, v, __ATOMIC_RELAXED, __HIP_MEMORY_SCOPE_AGENT); }
__device__ __forceinline__ unsigned xb_xcc_id() { return (unsigned)__builtin_amdgcn_s_getreg((3 << 11) | 20) & 0xFu; }
#define XB_SPIN(cond, bar) do { unsigned _sp = 0; while (cond) { __builtin_amdgcn_s_sleep(1); \
    if ((++_sp & 255u) == 0u) { if (xb_ld(&(bar)[XB_TMO])) break; if (_sp > XB_SPIN_CAP) { atomicAdd(&(bar)[XB_TMO], 1u); break; } } } } while (0)
struct XcdBarrier { unsigned* bar; unsigned x; volatile LAS unsigned* st; };
__device__ __forceinline__ XcdBarrier xcd_barrier_post(unsigned* bar, volatile LAS unsigned* st) {
    XcdBarrier b; b.bar = bar; b.x = xb_xcc_id(); b.st = st;
    if (threadIdx.x == 0) (void)xb_add(&bar[XB_XCNT(b.x)], 1u);
    return b;
}
__device__ __forceinline__ void xcd_barrier_complete(unsigned* bar, unsigned x, unsigned& nloc, unsigned& nx) {
    const unsigned G = gridDim.x * gridDim.y * gridDim.z;
    unsigned sum, cnt, mine, sp = 0u;
    for (;;) {
        sum = 0u; cnt = 0u; mine = 0u;
#pragma unroll
        for (unsigned j = 0; j < 16; ++j) { const unsigned c = xb_ld(&bar[XB_XCNT(j)]); sum += c; cnt += (c > 0u) ? 1u : 0u; mine = (j == x) ? c : mine; }
        if (sum == G) break;
        __builtin_amdgcn_s_sleep(1);
        if ((++sp & 255u) == 0u) { if (xb_ld(&bar[XB_TMO])) break; if (sp > XB_SPIN_CAP) { atomicAdd(&bar[XB_TMO], 1u); break; } }
    }
    nloc = mine > 0u ? mine : 1u; nx = cnt > 0u ? cnt : 1u;
}
__device__ __forceinline__ void xcd_barrier(const XcdBarrier& b) {
    asm volatile("s_waitcnt vmcnt(0)" ::: "memory");
    __syncthreads();
    if (threadIdx.x == 0) {
        unsigned* bar = b.bar;
        __builtin_amdgcn_s_waitcnt(0);
        unsigned nloc = b.st[0], nx = b.st[1];
        if (nloc == 0u) { xcd_barrier_complete(bar, b.x, nloc, nx); b.st[0] = nloc; b.st[1] = nx; }
        const unsigned old = xb_add(&bar[XB_XSUB(b.x)], 1u);
        const unsigned gen = old / nloc;
        if (old + 1u == (gen + 1u) * nloc) {
            __builtin_amdgcn_fence(__ATOMIC_RELEASE, "agent");
            asm volatile("s_waitcnt vmcnt(0)" ::: "memory");
            const unsigned og = xb_add(&bar[XB_TOP], 1u);
            const unsigned tg = og / nx;
            if (og + 1u == (tg + 1u) * nx) xb_add(&bar[XB_TOPGEN], 1u);
            else XB_SPIN(xb_ld(&bar[XB_TOPGEN]) == tg, bar);
            __builtin_amdgcn_fence(__ATOMIC_ACQUIRE, "agent");
            xb_add(&bar[XB_XGEN(b.x)], 1u);
            asm volatile("s_waitcnt vmcnt(0)" ::: "memory");
        } else {
            XB_SPIN(xb_ld(&bar[XB_XGEN(b.x)]) == gen, bar);
            __builtin_amdgcn_fence(__ATOMIC_ACQUIRE, "agent");
            asm volatile("s_waitcnt vmcnt(0)" ::: "memory");
        }
    }
    __syncthreads();
}

namespace pg8 {
constexpr int BM = 256, BK = 64, HALF = 128, HTB = HALF * BK * 2, STAGE_BYTES = 8 * HTB, NXCD = 8, WGM = 8;
__host__ __device__ __forceinline__ int lds_byte(int r, int c) { const int st = (r >> 4) * 2 + (c >> 5), rr = r & 15, cc = c & 31, ob = rr * 64 + cc * 2; return st * 1024 + (ob ^ (((ob >> 9) & 1) << 5)); }
__host__ __device__ __forceinline__ void stage_rc(int b, int& R, int& C) { const int st = b / 1024, sb = b % 1024, swz = sb ^ (((sb >> 9) & 1) << 5); R = (st >> 1) * 16 + swz / 64; C = (st & 1) * 32 + (swz % 64) / 2; }
__host__ __device__ __forceinline__ int perm32(int rho) { const int n = rho >> 4, i = rho & 15; return 8 * (i >> 2) + 4 * n + (i & 3); }

struct Unit { int pm, pn, pb, e, nv, lb; };
struct Gemm { const bf16* A; const bf16* Bt; int K; };

struct StaticOrder {
    int nM, nN, nwg, G, c;
    __device__ void init(int M, int N, int G_, int c_) { nM = M / BM; nN = N / BM; nwg = nM * nN; G = G_; c = c_; }
    __device__ bool next(int i, Unit& u) const {
        const long L = (long)i * G + c; if (L >= nwg) return false;
        int wgid = (int)L; { const int q = nwg / NXCD, r = nwg % NXCD, xcd = wgid % NXCD, off = wgid / NXCD; wgid = (xcd < r ? xcd * (q + 1) : r * (q + 1) + (xcd - r) * q) + off; }
        const int nig = WGM * nN, gid = wgid / nig, fm = gid * WGM, gsz = (nM - fm) < WGM ? (nM - fm) : WGM;
        u.pm = fm + ((wgid % nig) % gsz); u.pn = (wgid % nig) / gsz; u.pb = u.pn; u.e = 0; u.nv = 256; u.lb = 0; return true;
    }
    __device__ __forceinline__ unsigned arow(const Unit& u, int row) const { return (unsigned)(u.pm * 256 + row); }
};
struct PairOrder {
    StaticOrder S;
    __device__ bool next(int i, Unit& u) const { if (!S.next(i >> 1, u)) return false; u.pn = 2 * u.pn + (i & 1); u.pb = u.pn; return true; }
    __device__ __forceinline__ unsigned arow(const Unit& u, int row) const { return (unsigned)(u.pm * 256 + row); }
};
struct MoeOrder {
    const LAS int* tst; const LAS int* cnt; const int* list; int nN, bx, G, shift;
    __device__ bool next(int i, Unit& u) const {
        int pn, rt;
        if (nN == 8) { pn = bx & 7; rt = (bx >> 3) + (G >> 3) * i; }
        else { pn = bx & 3; rt = 2 * ((bx >> 3) + (G >> 3) * i) + ((bx >> 2) & 1); }
        if (rt >= __builtin_amdgcn_readfirstlane(tst[32])) return false;
        int e = 0;
#pragma unroll 1
        for (int j = 1; j < 32; ++j) e = (__builtin_amdgcn_readfirstlane(tst[j]) <= rt) ? j : e;
        const int t0 = __builtin_amdgcn_readfirstlane(tst[e]), ce = __builtin_amdgcn_readfirstlane(cnt[e]);
        u.pm = rt; u.pn = pn; u.pb = e * nN + pn; u.e = e; const int r0 = (rt - t0) * 256; const int left = ce - r0; u.nv = left < 256 ? left : 256; u.lb = e * CAP + r0; return true;
    }
    __device__ __forceinline__ unsigned arow(const Unit& u, int row) const { const int r = row < u.nv ? row : u.nv - 1; return (unsigned)(list[u.lb + r] >> shift); }
};

__device__ __forceinline__ unsigned cvt_pk_bf16(float lo, float hi) { unsigned r; asm volatile("v_cvt_pk_bf16_f32 %0, %1, %2" : "=v"(r) : "v"(lo), "v"(hi)); return r; }

template <class Epi, class Sched, bool GATHER>
__device__ __forceinline__ void gemm_phase(LAS unsigned char* lds, const Gemm g, const Sched& S, const Epi& E) {
    int tid_ = threadIdx.x; asm volatile("" : "+v"(tid_));
    const int tid = tid_, wid = __builtin_amdgcn_readfirstlane(tid >> 6), lane = tid & 63, wr = wid >> 2, wc = wid & 3, fr = lane & 15, fq = lane >> 4;
    const int K = g.K, nt = K / BK;
    int sR[2], sC[2]; unsigned voffB[2], voffA[2];
#pragma unroll
    for (int i = 0; i < 2; ++i) { stage_rc(tid * 16 + i * 8192, sR[i], sC[i]); const int Rb = Epi::PERM ? ((sR[i] & ~31) + perm32(sR[i] & 31)) : sR[i];
        voffB[i] = (unsigned)(Rb * K + sC[i]) * 2u; voffA[i] = (unsigned)(sR[i] * K + sC[i]) * 2u; }
    const unsigned kstep = (unsigned)(BK * 2);
    const unsigned hstep = (unsigned)HALF * (unsigned)K * 2u;
    const unsigned tstep = 2u * hstep;
    const unsigned ldsw = (unsigned)wid * 1024u;
    const int aoff = lds_byte(wr * 64 + fr, fq * 8), boff = lds_byte(wc * 32 + fr, fq * 8);
    const __amdgpu_buffer_rsrc_t rA = __builtin_amdgcn_make_buffer_rsrc((void*)g.A, 0, 0xfffff000u, 0x00020000);
    const __amdgpu_buffer_rsrc_t rB = __builtin_amdgcn_make_buffer_rsrc((void*)g.Bt, 0, 0xfffff000u, 0x00020000);
#define PG8_SA(b, h) (((b) * 2 + (h)) * HTB)
#define PG8_SB(b, h) ((4 + (b) * 2 + (h)) * HTB)
#define PG8_STAGE(bufoff, soff) do { _Pragma("unroll") for (int _i = 0; _i < 2; ++_i) \
        __builtin_amdgcn_raw_ptr_buffer_load_lds(rB, (LAS unsigned*)(lds + (bufoff) + ldsw + _i * 8192), 16, voffB[_i], (int)(soff), 0, 0); } while (0)
#define PG8_STAGEA(bufoff, soff, h, NX) do { _Pragma("unroll") for (int _i = 0; _i < 2; ++_i) { const unsigned _o = GATHER ? ((NX) ? vAn[h][_i] : vAc[h][_i]) : voffA[_i]; \
        __builtin_amdgcn_raw_ptr_buffer_load_lds(rA, (LAS unsigned*)(lds + (bufoff) + ldsw + _i * 8192), 16, _o, (int)((soff) + (GATHER ? 0u : (unsigned)(h) * hstep)), 0, 0); } } while (0)
#define PG8_LDA(dst, b, h) do { _Pragma("unroll") for (int m = 0; m < 4; ++m) _Pragma("unroll") for (int k = 0; k < 2; ++k) dst[m][k] = *(const LAS bf16x8*)(lds + PG8_SA(b, h) + aoff + m * 2048 + k * 1024); } while (0)
#define PG8_LDB(dst, b, h) do { _Pragma("unroll") for (int n = 0; n < 2; ++n) _Pragma("unroll") for (int k = 0; k < 2; ++k) dst[n][k] = *(const LAS bf16x8*)(lds + PG8_SB(b, h) + boff + n * 2048 + k * 1024); } while (0)
#define PG8_MMA(ai, bj, At, Bt) do { __builtin_amdgcn_s_setprio(1); _Pragma("unroll") for (int m = 0; m < 4; ++m) _Pragma("unroll") for (int n = 0; n < 2; ++n) _Pragma("unroll") for (int k = 0; k < 2; ++k) \
        acc[ai][bj][m][n] = __builtin_amdgcn_mfma_f32_16x16x32_bf16(Bt[n][k], At[m][k], acc[ai][bj][m][n], 0, 0, 0); __builtin_amdgcn_s_setprio(0); } while (0)
#define PG8_WAIT_V(n) asm volatile("s_waitcnt vmcnt(" #n ")" ::: "memory")
#define PG8_WAIT_L(n) asm volatile("s_waitcnt lgkmcnt(" #n ")" ::: "memory")
#define PG8_BAR __builtin_amdgcn_s_barrier()
#define PG8_SCHED __builtin_amdgcn_sched_barrier(0)
    Unit cur, nxt; int ui = 0;
    if (!S.next(0, cur)) return;
    unsigned vAc[2][2], vAn[2][2];
#define PG8_AOFF(dst, u) do { _Pragma("unroll") for (int _h = 0; _h < 2; ++_h) _Pragma("unroll") for (int _i = 0; _i < 2; ++_i) \
        dst[_h][_i] = S.arow(u, _h * HALF + sR[_i]) * (unsigned)(K * 2) + (unsigned)(sC[_i] * 2); } while (0)
    if (GATHER) { PG8_AOFF(vAc, cur); }
    f32x4 acc[2][2][4][2];
#pragma unroll
    for (int a = 0; a < 2; ++a)
#pragma unroll
        for (int b = 0; b < 2; ++b)
#pragma unroll
            for (int m = 0; m < 4; ++m)
#pragma unroll
                for (int n = 0; n < 2; ++n) acc[a][b][m][n] = (f32x4){0.f, 0.f, 0.f, 0.f};
    bf16x8 At[4][2], B0[2][2], B1[2][2];
    unsigned cA = GATHER ? 0u : (unsigned)cur.pm * tstep, cB = (unsigned)cur.pb * tstep;
    PG8_STAGE(PG8_SB(0, 0), cB); PG8_STAGE(PG8_SB(0, 1), cB + hstep); PG8_STAGEA(PG8_SA(0, 0), cA, 0, false); PG8_STAGEA(PG8_SA(0, 1), cA, 1, false);
    if (wr == 1) PG8_BAR;
    PG8_WAIT_V(2); PG8_BAR;
    PG8_STAGE(PG8_SB(1, 0), cB + kstep); PG8_STAGEA(PG8_SA(1, 0), cA + kstep, 0, false); PG8_STAGE(PG8_SB(1, 1), cB + hstep + kstep);
    PG8_WAIT_V(6); PG8_BAR;
    for (;;) {
        const bool has_next = S.next(ui + 1, nxt);
        const unsigned nA = has_next ? (GATHER ? 0u : (unsigned)nxt.pm * tstep) : cA, nB = has_next ? (unsigned)nxt.pb * tstep : cB;
        if (GATHER) { if (has_next) { PG8_AOFF(vAn, nxt); } else {
#pragma unroll
            for (int _h = 0; _h < 2; ++_h)
#pragma unroll
                for (int _i = 0; _i < 2; ++_i) vAn[_h][_i] = vAc[_h][_i]; } }
        for (int t = 0; t < nt; t += 2) {
            const bool last = (t == nt - 2);
            const unsigned a1 = cA + (unsigned)(t + 1) * kstep;
            const unsigned a2 = last ? nA : cA + (unsigned)(t + 2) * kstep, b2 = last ? nB : cB + (unsigned)(t + 2) * kstep;
            const unsigned a3 = a2 + kstep, b3 = b2 + kstep;
            PG8_LDB(B0, 0, 0); PG8_LDB(B1, 0, 1); PG8_SCHED; PG8_LDA(At, 0, 0); PG8_STAGEA(PG8_SA(1, 1), a1, 1, false);
            PG8_WAIT_V(8); PG8_WAIT_L(0); PG8_BAR; PG8_MMA(0, 0, At, B0); PG8_MMA(0, 1, At, B1); PG8_BAR; PG8_SCHED;
            PG8_LDA(At, 0, 1); PG8_STAGE(PG8_SB(0, 0), b2); PG8_STAGE(PG8_SB(0, 1), b2 + hstep); PG8_STAGEA(PG8_SA(0, 0), a2, 0, last);
            PG8_WAIT_V(8); PG8_WAIT_L(0); PG8_BAR; PG8_MMA(1, 0, At, B0); PG8_MMA(1, 1, At, B1); PG8_BAR; PG8_SCHED;
            PG8_LDB(B0, 1, 0); PG8_LDB(B1, 1, 1); PG8_SCHED; PG8_LDA(At, 1, 0); PG8_STAGEA(PG8_SA(0, 1), a2, 1, last);
            PG8_WAIT_V(8); PG8_WAIT_L(0); PG8_BAR; PG8_MMA(0, 0, At, B0); PG8_MMA(0, 1, At, B1); PG8_BAR; PG8_SCHED;
            PG8_LDA(At, 1, 1); PG8_STAGE(PG8_SB(1, 0), b3); PG8_STAGE(PG8_SB(1, 1), b3 + hstep); PG8_STAGEA(PG8_SA(1, 0), a3, 0, last);
            PG8_WAIT_V(8); PG8_WAIT_L(0); PG8_BAR; PG8_MMA(1, 0, At, B0); PG8_MMA(1, 1, At, B1); PG8_BAR; PG8_SCHED;
        }
        if (wr == 0) PG8_BAR;
        E(acc, cur, wr, wc, fr, fq);
        if (!has_next) break;
#pragma unroll
        for (int a = 0; a < 2; ++a)
#pragma unroll
            for (int b = 0; b < 2; ++b)
#pragma unroll
                for (int m = 0; m < 4; ++m)
#pragma unroll
                    for (int n = 0; n < 2; ++n) acc[a][b][m][n] = (f32x4){0.f, 0.f, 0.f, 0.f};
        cur = nxt; cA = nA; cB = nB; ++ui;
        if (GATHER) {
#pragma unroll
            for (int _h = 0; _h < 2; ++_h)
#pragma unroll
                for (int _i = 0; _i < 2; ++_i) vAc[_h][_i] = vAn[_h][_i]; }
        if (wr == 1) PG8_BAR;
    }
    PG8_WAIT_V(0);
    PG8_BAR;
#undef PG8_SA
#undef PG8_SB
#undef PG8_STAGE
#undef PG8_STAGEA
#undef PG8_LDA
#undef PG8_LDB
#undef PG8_MMA
#undef PG8_WAIT_V
#undef PG8_WAIT_L
#undef PG8_BAR
#undef PG8_SCHED
#undef PG8_AOFF
}
}
namespace epi {
using pg8::Unit; using pg8::HALF;
typedef const f32x4 (&AccRef)[2][2][4][2];
__device__ __forceinline__ u32x4 pack8(const f32x4 a, const f32x4 b) { u32x4 w; w.x = pk2(a[0], a[1]); w.y = pk2(a[2], a[3]); w.z = pk2(b[0], b[1]); w.w = pk2(b[2], b[3]); return w; }
__device__ __forceinline__ void unpack8(const u32x4 w, f32x4& a, f32x4& b) { a = (f32x4){bflo(w.x), bfhi(w.x), bflo(w.y), bfhi(w.y)}; b = (f32x4){bflo(w.z), bfhi(w.z), bflo(w.w), bfhi(w.w)}; }

struct EpiInProj {
    static constexpr bool PERM = true;
    bf16 *QH, *KH, *VT, *U, *SGA, *SGS; const float* gq; const float* gk;
    __device__ __forceinline__ void operator()(AccRef acc, const Unit& u, int wr, int wc, int fr, int fq) const {
        const int pn = u.pn;
        if (pn < 4) {
            const int which = pn >> 1, h = (pn & 1) * 4 + wc; const float* g = which ? gk : gq; bf16* dst = which ? KH : QH; const float qs = which ? 1.f : 0.125f * 1.4426950408889634f;
            f32x4 gv[2][2];
#pragma unroll
            for (int bj = 0; bj < 2; ++bj)
#pragma unroll
                for (int n = 0; n < 2; ++n) gv[bj][n] = *(const f32x4*)(g + 32 * bj + 8 * fq + 4 * n);
#pragma unroll
            for (int ai = 0; ai < 2; ++ai)
#pragma unroll
                for (int m = 0; m < 4; ++m) {
                    float ss = 0.f;
#pragma unroll
                    for (int bj = 0; bj < 2; ++bj)
#pragma unroll
                        for (int n = 0; n < 2; ++n) { const f32x4 v = acc[ai][bj][m][n]; ss += (v[0] * v[0] + v[1] * v[1]) + (v[2] * v[2] + v[3] * v[3]); }
                    ss += __shfl_xor(ss, 16); ss += __shfl_xor(ss, 32);
                    const float rs = rsqrtf(ss * (1.f / 64.f) + EPS) * qs;
                    const int row = u.pm * 256 + ai * HALF + wr * 64 + m * 16 + fr, b = row >> 11, s = row & 2047;
                    bf16* rp = dst + ((size_t)(b * NHEAD + h) * SEQ + s) * HD + 8 * fq;
#pragma unroll
                    for (int bj = 0; bj < 2; ++bj) *(u32x4*)(rp + 32 * bj) = pack8(acc[ai][bj][m][0] * rs * gv[bj][0], acc[ai][bj][m][1] * rs * gv[bj][1]);
                    asm volatile("" ::: "memory");
                }
        } else if (pn < 6) {
            const __amdgpu_buffer_rsrc_t rv = __builtin_amdgcn_make_buffer_rsrc((void*)VT, 0, 0x7ffff000u, 0x00020000);
            const int cw = (pn - 4) * 256 + 32 * wc + 8 * fq;
#pragma unroll
            for (int ai = 0; ai < 2; ++ai)
#pragma unroll
                for (int m = 0; m < 4; ++m) {
                    const int row = u.pm * 256 + ai * HALF + wr * 64 + m * 16 + fr, b = row >> 11, s = row & 2047;
                    const unsigned vo = (unsigned)(((b * 512 + cw) * SEQ + s) * 2);
#pragma unroll
                    for (int bj = 0; bj < 2; ++bj)
#pragma unroll
                        for (int n = 0; n < 2; ++n)
#pragma unroll
                            for (int i = 0; i < 4; ++i)
                                __builtin_amdgcn_raw_buffer_store_b16((short)f2bf(acc[ai][bj][m][n][i]), rv, vo, (128 * bj + 4 * n + i) * SEQ * 2, 0);
                    asm volatile("" ::: "memory");
                }
        } else if (pn < 8) {
#pragma unroll
            for (int ai = 0; ai < 2; ++ai)
#pragma unroll
                for (int m = 0; m < 4; ++m) { const int row = u.pm * 256 + ai * HALF + wr * 64 + m * 16 + fr;
#pragma unroll
                    for (int bj = 0; bj < 2; ++bj) *(u32x4*)(U + (size_t)row * 512 + (pn - 6) * 256 + 128 * bj + 32 * wc + 8 * fq) = pack8(acc[ai][bj][m][0], acc[ai][bj][m][1]); asm volatile("" ::: "memory"); }
        } else {
            bf16* dst = pn < 12 ? SGA : SGS; const int ct = ((pn - 8) & 3) * 256;
#pragma unroll
            for (int ai = 0; ai < 2; ++ai)
#pragma unroll
                for (int m = 0; m < 4; ++m) { const int row = u.pm * 256 + ai * HALF + wr * 64 + m * 16 + fr;
#pragma unroll
                    for (int bj = 0; bj < 2; ++bj) { f32x4 a = acc[ai][bj][m][0], b = acc[ai][bj][m][1];
#pragma unroll
                        for (int i = 0; i < 4; ++i) { a[i] = sigm(a[i]); b[i] = sigm(b[i]); }
                        *(u32x4*)(dst + (size_t)row * DM + ct + 128 * bj + 32 * wc + 8 * fq) = pack8(a, b); } asm volatile("" ::: "memory"); }
        }
    }
};
struct EpiPle {
    static constexpr bool PERM = true;
    bf16* PP; float* PSS;
    __device__ __forceinline__ void operator()(AccRef acc, const Unit& u, int wr, int wc, int fr, int fq) const {
#pragma unroll
        for (int ai = 0; ai < 2; ++ai)
#pragma unroll
            for (int m = 0; m < 4; ++m) { const int row = u.pm * 256 + ai * HALF + wr * 64 + m * 16 + fr; float ss = 0.f;
#pragma unroll
                for (int bj = 0; bj < 2; ++bj) {
#pragma unroll
                    for (int n = 0; n < 2; ++n) { const f32x4 v = acc[ai][bj][m][n]; ss += (v[0] * v[0] + v[1] * v[1]) + (v[2] * v[2] + v[3] * v[3]); }
                    *(u32x4*)(PP + (size_t)row * DM + u.pn * 256 + 128 * bj + 32 * wc + 8 * fq) = pack8(acc[ai][bj][m][0], acc[ai][bj][m][1]); }
                ss += __shfl_xor(ss, 16); ss += __shfl_xor(ss, 32);
                if (fq == 0) PSS[(size_t)row * 16 + u.pn * 4 + wc] = ss; asm volatile("" ::: "memory"); }
    }
};
struct EpiT1 {
    static constexpr bool PERM = true;
    const bf16* SGA; bf16* T1;
    __device__ __forceinline__ void operator()(AccRef acc, const Unit& u, int wr, int wc, int fr, int fq) const {
#pragma unroll
        for (int ai = 0; ai < 2; ++ai)
#pragma unroll
            for (int m = 0; m < 4; ++m) { const size_t off = (size_t)(u.pm * 256 + ai * HALF + wr * 64 + m * 16 + fr) * DM + u.pn * 256 + 32 * wc + 8 * fq;
#pragma unroll
                for (int bj = 0; bj < 2; ++bj) { f32x4 ga, gb; unpack8(*(const u32x4*)(SGA + off + 128 * bj), ga, gb); *(u32x4*)(T1 + off + 128 * bj) = pack8(acc[ai][bj][m][0] * ga, acc[ai][bj][m][1] * gb); } asm volatile("" ::: "memory"); }
    }
};
struct EpiGlu {
    static constexpr bool PERM = true;
    const bf16* T1; const bf16* SGS; const float* bg; bf16* MIX;
    __device__ __forceinline__ void operator()(AccRef acc, const Unit& u, int wr, int wc, int fr, int fq) const {
        const int c0 = u.pn * 128 + 32 * wc + 8 * fq;
        const f32x4 b10 = *(const f32x4*)(bg + c0), b11 = *(const f32x4*)(bg + c0 + 4), b20 = *(const f32x4*)(bg + 1024 + c0), b21 = *(const f32x4*)(bg + 1024 + c0 + 4);
#pragma unroll
        for (int ai = 0; ai < 2; ++ai)
#pragma unroll
            for (int m = 0; m < 4; ++m) { const size_t off = (size_t)(u.pm * 256 + ai * HALF + wr * 64 + m * 16 + fr) * DM + c0;
                f32x4 ta, tb, sa, sb; unpack8(*(const u32x4*)(T1 + off), ta, tb); unpack8(*(const u32x4*)(SGS + off), sa, sb);
                f32x4 z1a = acc[ai][0][m][0] + b10, z1b = acc[ai][0][m][1] + b11, z2a = acc[ai][1][m][0] + b20, z2b = acc[ai][1][m][1] + b21;
#pragma unroll
                for (int i = 0; i < 4; ++i) { ta[i] += sa[i] * z1a[i] * sigm(z2a[i]); tb[i] += sb[i] * z1b[i] * sigm(z2b[i]); }
                *(u32x4*)(MIX + off) = pack8(ta, tb); asm volatile("" ::: "memory"); }
    }
};
struct EpiX2 {
    static constexpr bool PERM = false;
    const float* X; float* X2;
    __device__ __forceinline__ void operator()(AccRef acc, const Unit& u, int wr, int wc, int fr, int fq) const {
#pragma unroll
        for (int ai = 0; ai < 2; ++ai)
#pragma unroll
            for (int m = 0; m < 4; ++m) { const size_t off = (size_t)(u.pm * 256 + ai * HALF + wr * 64 + m * 16 + fr) * DM + u.pn * 256 + 32 * wc + 4 * fq;
#pragma unroll
                for (int bj = 0; bj < 2; ++bj)
#pragma unroll
                    for (int n = 0; n < 2; ++n) *(f32x4*)(X2 + off + 128 * bj + 16 * n) = *(const f32x4*)(X + off + 128 * bj + 16 * n) + acc[ai][bj][m][n]; asm volatile("" ::: "memory"); }
    }
};
struct EpiUp {
    static constexpr bool PERM = true;
    const float* bup; bf16* ACT;
    __device__ __forceinline__ void operator()(AccRef acc, const Unit& u, int wr, int wc, int fr, int fq) const {
        const int c0 = u.pn * 128 + 32 * wc + 8 * fq; const float* bg = bup + (size_t)u.e * 2048;
        const f32x4 b10 = *(const f32x4*)(bg + c0), b11 = *(const f32x4*)(bg + c0 + 4), b20 = *(const f32x4*)(bg + 1024 + c0), b21 = *(const f32x4*)(bg + 1024 + c0 + 4);
#pragma unroll
        for (int ai = 0; ai < 2; ++ai)
#pragma unroll
            for (int m = 0; m < 4; ++m) { const size_t off = (size_t)(u.pm * 256 + ai * HALF + wr * 64 + m * 16 + fr) * DM + c0;
                f32x4 ga = acc[ai][0][m][0] + b10, gb = acc[ai][0][m][1] + b11, ua = acc[ai][1][m][0] + b20, ub = acc[ai][1][m][1] + b21;
#pragma unroll
                for (int i = 0; i < 4; ++i) { const float g0 = fminf(ga[i], 7.f), g1 = fminf(gb[i], 7.f), u0 = fminf(fmaxf(ua[i], -7.f), 7.f), u1 = fminf(fmaxf(ub[i], -7.f), 7.f);
                    ga[i] = (u0 + 1.f) * g0 * sigm(1.702f * g0); gb[i] = (u1 + 1.f) * g1 * sigm(1.702f * g1); }
                *(u32x4*)(ACT + off) = pack8(ga, gb); asm volatile("" ::: "memory"); }
    }
};
struct EpiDown {
    static constexpr bool PERM = true;
    const float* bdn; const int* list; bf16* YS;
    __device__ __forceinline__ void operator()(AccRef acc, const Unit& u, int wr, int wc, int fr, int fq) const {
        const int c0 = u.pn * 256 + 32 * wc + 8 * fq; const float* bb = bdn + (size_t)u.e * 1024;
        f32x4 bv[2][2];
#pragma unroll
        for (int bj = 0; bj < 2; ++bj)
#pragma unroll
            for (int n = 0; n < 2; ++n) bv[bj][n] = *(const f32x4*)(bb + c0 + 128 * bj + 4 * n);
#pragma unroll
        for (int ai = 0; ai < 2; ++ai)
#pragma unroll
            for (int m = 0; m < 4; ++m) { const int rl = ai * HALF + wr * 64 + m * 16 + fr;
                if (rl < u.nv) { const int pair = list[u.lb + rl];
#pragma unroll
                    for (int bj = 0; bj < 2; ++bj) *(u32x4*)(YS + (size_t)pair * DM + c0 + 128 * bj) = pack8(acc[ai][bj][m][0] + bv[bj][0], acc[ai][bj][m][1] + bv[bj][1]); } asm volatile("" ::: "memory"); }
    }
};
struct EpiFinal {
    static constexpr bool PERM = false;
    float* OUT; const bf16* PP; const float* PSS; const float* gpost;
    __device__ __forceinline__ void operator()(AccRef acc, const Unit& u, int wr, int wc, int fr, int fq) const {
        const int cb = u.pn * 256 + 32 * wc + 4 * fq;
        f32x4 gp[2][2];
#pragma unroll
        for (int bj = 0; bj < 2; ++bj)
#pragma unroll
            for (int n = 0; n < 2; ++n) gp[bj][n] = *(const f32x4*)(gpost + cb + 128 * bj + 16 * n);
#pragma unroll
        for (int ai = 0; ai < 2; ++ai)
#pragma unroll
            for (int m = 0; m < 4; ++m) { const int row = u.pm * 256 + ai * HALF + wr * 64 + m * 16 + fr; const size_t off = (size_t)row * DM + cb;
                const f32x4* ps = (const f32x4*)(PSS + (size_t)row * 16); const f32x4 p0 = ps[0], p1 = ps[1], p2 = ps[2], p3 = ps[3];
                const float tot = ((p0[0] + p0[1]) + (p0[2] + p0[3])) + ((p1[0] + p1[1]) + (p1[2] + p1[3])) + ((p2[0] + p2[1]) + (p2[2] + p2[3])) + ((p3[0] + p3[1]) + (p3[2] + p3[3]));
                const float rp = rsqrtf(tot * (1.f / DM) + EPS);
#pragma unroll
                for (int bj = 0; bj < 2; ++bj)
#pragma unroll
                    for (int n = 0; n < 2; ++n) { const u32x2 pw = *(const u32x2*)(PP + off + 128 * bj + 16 * n); const f32x4 pv = (f32x4){bflo(pw.x), bfhi(pw.x), bflo(pw.y), bfhi(pw.y)};
                        f32x4 o = *(const f32x4*)(OUT + off + 128 * bj + 16 * n); const f32x4 a = acc[ai][bj][m][n];
#pragma unroll
                        for (int i = 0; i < 4; ++i) o[i] += sigm(a[i]) * (pv[i] * rp * gp[bj][n][i]);
                        *(f32x4*)(OUT + off + 128 * bj + 16 * n) = o; } asm volatile("" ::: "memory"); }
    }
};
}
struct Frame {
    LAS unsigned char* lds; gu32* ctl; int tid, lane, wave, G, bx;
    unsigned char* ws; float* out;
};
constexpr int PTAB_OFF = LDSCTL_OFF + 1024;
__device__ __forceinline__ const float* fin_load(const Frame& F, int i) {
    const unsigned long long v = ((const LAS unsigned long long*)(F.lds + PTAB_OFF))[i];
    const unsigned lo = __builtin_amdgcn_readfirstlane((unsigned)v), hi = __builtin_amdgcn_readfirstlane((unsigned)(v >> 32));
    return (const float*)(((unsigned long long)hi << 32) | lo);
}
#define FIN(i) (fin_load(F, (i)))
template <class T> __device__ __forceinline__ T* wsp(const Frame& F, size_t off) { return (T*)(F.ws + off); }
__device__ __forceinline__ int fresh_tid() { int t = threadIdx.x; asm volatile("" : "+v"(t)); return t; }

__device__ __forceinline__ void p0_transpose_item(const float* W, int K, int N, bf16* WT, int prow, LAS float* scr, int kb, int nb, int lane) {
    const int k0 = 64 * kb, n0 = 32 * nb;
#pragma unroll 8
    for (int i = 0; i < 32; ++i) { const int kk = 2 * i + (lane >> 5); scr[kk * 33 + (lane & 31)] = W[(size_t)(k0 + kk) * N + n0 + (lane & 31)]; }
    LDS_WAIT(); asm volatile("" ::: "memory");
    const int c = lane & 7;
#pragma unroll
    for (int j = 0; j < 4; ++j) { const int n = (lane >> 3) + 8 * j; const LAS float* s = scr + (8 * c) * 33 + n;
        u32x4 o; o.x = pk2(s[0 * 33], s[1 * 33]); o.y = pk2(s[2 * 33], s[3 * 33]); o.z = pk2(s[4 * 33], s[5 * 33]); o.w = pk2(s[6 * 33], s[7 * 33]);
        *(GAS u32x4*)(WT + (size_t)(prow + n) * K + k0 + 8 * c) = o; }
    LDS_WAIT(); asm volatile("" ::: "memory");
}
__device__ __forceinline__ int prow0(int kind, int n0) {
    if (kind == 1) { if (n0 < 1024) { const int pn = n0 >> 8, wcb = (n0 >> 6) & 3, bjb = (n0 >> 5) & 1; return 256 * pn + 128 * bjb + 32 * wcb; } return n0; }
    if (kind == 2) { const int bj = n0 >> 10, rem = n0 & 1023; return 256 * (rem >> 7) + 128 * bj + (rem & 127); }
    return n0;
}
__device__ __forceinline__ void abar_pow(float lr, float li, float dt, int n, float& er, float& ei) {
    const double rev = (double)li * (double)dt * (double)n * 0.15915494309189535;
    const float f = (float)(rev - __builtin_rint(rev));
    const float mag = expf(lr * dt * (float)n);
    er = mag * __builtin_amdgcn_cosf(f); ei = mag * __builtin_amdgcn_sinf(f);
}
__device__ __forceinline__ void zoh_f(float lr, float li, float dt, float& fr, float& fi) {
    float ar, ai; abar_pow(lr, li, dt, 1, ar, ai);
    const float den = lr * lr + li * li, nr = ar - 1.f; fr = (nr * lr + ai * li) / den; fi = (ai * lr - nr * li) / den;
}
constexpr int IT_WIN = 16 * 128, IT_WAB = 8 * 32, IT_WGLU = 8 * 64, IT_WOUT = 16 * 32, IT_WPG = 16 * 32, IT_WPP = 4 * 32, IT_WUP1 = 16 * 64, IT_WDN1 = 16 * 32;
constexpr int IT_T0 = 0, IT_T1 = IT_T0 + IT_WIN, IT_T2 = IT_T1 + IT_WAB, IT_T3 = IT_T2 + IT_WGLU, IT_T4 = IT_T3 + IT_WOUT, IT_T5 = IT_T4 + IT_WPG, IT_T6 = IT_T5 + IT_WPP, IT_T7 = IT_T6 + 32 * IT_WUP1,
              IT_T8 = IT_T7 + 32 * IT_WDN1;
constexpr int IT_XN = IT_T8, IT_PBF = IT_XN + NTOK, IT_PT = IT_PBF + 4096, IT_RT = IT_PT + 2048, IT_MT = IT_RT + 2048, IT_A64 = IT_MT + 32 * 65, IT_END = IT_A64 + 32;
struct TItem { const float* src; bf16* dst; int N, K; };
__device__ __forceinline__ void p0_decode(Frame& F, int it, TItem& t) {
    const float* W; bf16* WT; int K, N, kind, r;
    if (it < IT_T1) { r = it - IT_T0; W = FIN(3); K = 1024; N = 4096; kind = 1; WT = wsp<bf16>(F, WS_WIN); }
    else if (it < IT_T2) { r = it - IT_T1; W = FIN(6); K = 512; N = 1024; kind = 0; WT = wsp<bf16>(F, WS_WAB); }
    else if (it < IT_T3) { r = it - IT_T2; W = FIN(15); K = 512; N = 2048; kind = 2; WT = wsp<bf16>(F, WS_WGLU); }
    else if (it < IT_T4) { r = it - IT_T3; W = FIN(17); K = 1024; N = 1024; kind = 0; WT = wsp<bf16>(F, WS_WOUT); }
    else if (it < IT_T5) { r = it - IT_T4; W = FIN(26); K = 1024; N = 1024; kind = 0; WT = wsp<bf16>(F, WS_WPG); }
    else if (it < IT_T6) { r = it - IT_T5; W = FIN(27); K = 256; N = 1024; kind = 0; WT = wsp<bf16>(F, WS_WPP); }
    else if (it < IT_T7) { r = it - IT_T6; const int e = r / IT_WUP1; r -= e * IT_WUP1; W = FIN(21) + (size_t)e * 1024 * 2048; K = 1024; N = 2048; kind = 2; WT = wsp<bf16>(F, WS_WUP) + (size_t)e * 2048 * 1024; }
    else { r = it - IT_T7; const int e = r / IT_WDN1; r -= e * IT_WDN1; W = FIN(23) + (size_t)e * 1024 * 1024; K = 1024; N = 1024; kind = 0; WT = wsp<bf16>(F, WS_WDN) + (size_t)e * 1024 * 1024; }
    const int nblk = N / 32, kb = r / nblk, nb = r % nblk;
    t.src = W + (size_t)(64 * kb) * N + 32 * nb; t.dst = WT + (size_t)prow0(kind, 32 * nb) * K + 64 * kb; t.N = N; t.K = K;
}
__device__ __forceinline__ void p0_prologue(Frame& F, int sub) {
    LAS float* scr = (LAS float*)(F.lds + F.wave * 16384);
    const int lane = fresh_tid() & 63, gw = F.bx * NWAVES + F.wave, NGW = F.G * NWAVES;
    {
        const int lr = lane >> 3, lc = 4 * (lane & 7), c = lane & 7;
#define P0_LD(IT, T, V) do { if ((IT) < IT_T8) { p0_decode(F, (IT), T); _Pragma("unroll") for (int i = 0; i < 8; ++i) V[i] = *(const GAS f32x4*)(T.src + (size_t)(8 * i + lr) * T.N + lc); } } while (0)
#define P0_PROC(IT, T, V) do { if ((IT) < IT_T8) { \
            _Pragma("unroll") for (int i = 0; i < 8; ++i) { LAS float* d = scr + (8 * i + lr) * 33 + lc; d[0] = V[i][0]; d[1] = V[i][1]; d[2] = V[i][2]; d[3] = V[i][3]; } \
            LDS_WAIT(); asm volatile("" ::: "memory"); \
            _Pragma("unroll") for (int j = 0; j < 4; ++j) { const int n = (lane >> 3) + 8 * j; const LAS float* s_ = scr + (8 * c) * 33 + n; \
                u32x4 o; o.x = pk2(s_[0 * 33], s_[1 * 33]); o.y = pk2(s_[2 * 33], s_[3 * 33]); o.z = pk2(s_[4 * 33], s_[5 * 33]); o.w = pk2(s_[6 * 33], s_[7 * 33]); \
                *(GAS u32x4*)(T.dst + (size_t)n * T.K + 8 * c) = o; } \
            LDS_WAIT(); asm volatile("" ::: "memory"); } } while (0)
        TItem tA, tB, tC; f32x4 vA[8], vB[8], vC[8];
        int it = (sub & 1) ? IT_T8 : gw;
        P0_LD(it, tA, vA); P0_LD(it + NGW, tB, vB);
        while (it < IT_T8) {
            P0_LD(it + 2 * NGW, tC, vC); P0_PROC(it, tA, vA);
            P0_LD(it + 3 * NGW, tA, vA); P0_PROC(it + NGW, tB, vB);
            P0_LD(it + 4 * NGW, tB, vB); P0_PROC(it + 2 * NGW, tC, vC);
            it += 3 * NGW;
        }
#undef P0_LD
#undef P0_PROC
    }
    if (!(sub & 2) && !(sub & 4)) {
        const GAS f32x4* gr = (const GAS f32x4*)FIN(2) + lane; const float* X = FIN(0); bf16* XN = wsp<bf16>(F, WS_XN);
        f32x4 v[4], vn[4]; int row = gw;
        if (row < NTOK) {
#pragma unroll
            for (int j = 0; j < 4; ++j) v[j] = ((const GAS f32x4*)(X + (size_t)row * DM) + lane)[64 * j]; }
        while (row < NTOK) {
            const int nrow = row + NGW;
            if (nrow < NTOK) {
#pragma unroll
                for (int j = 0; j < 4; ++j) vn[j] = ((const GAS f32x4*)(X + (size_t)nrow * DM) + lane)[64 * j]; }
            float s = 0.f;
#pragma unroll
            for (int j = 0; j < 4; ++j) s += (v[j].x * v[j].x + v[j].y * v[j].y) + (v[j].z * v[j].z + v[j].w * v[j].w);
            const float r = rsqrtf(wave_sum(s) * (1.f / DM) + EPS);
            GAS u32x2* o8 = (GAS u32x2*)(XN + (size_t)row * DM) + lane;
#pragma unroll
            for (int j = 0; j < 4; ++j) { const f32x4 g = gr[64 * j]; u32x2 w; w.x = pk2(v[j].x * r * g.x, v[j].y * r * g.y); w.y = pk2(v[j].z * r * g.z, v[j].w * r * g.w); o8[64 * j] = w; }
#pragma unroll
            for (int j = 0; j < 4; ++j) v[j] = vn[j];
            row = nrow;
        }
    }
    for (int it = ((sub & 2) ? IT_END : IT_PBF + gw); it < IT_END; it += NGW) {
        if ((sub & 4) && it < IT_PT) continue; if ((sub & 8) && it >= IT_PT) continue;
        if (it < IT_PT) {
            const int q = it - IT_PBF; const GAS f32x4* pr = (const GAS f32x4*)(FIN(1) + (size_t)q * 1024) + lane; GAS u32x2* o8 = (GAS u32x2*)(wsp<bf16>(F, WS_PBF) + (size_t)q * 1024) + lane;
#pragma unroll
            for (int j = 0; j < 4; ++j) { const f32x4 v = pr[64 * j]; u32x2 w; w.x = pk2(v.x, v.y); w.y = pk2(v.z, v.w); o8[64 * j] = w; }
        } else {
            int r, kindt; if (it < IT_RT) { r = it - IT_PT; kindt = 0; } else if (it < IT_MT) { r = it - IT_RT; kindt = 1; } else if (it < IT_A64) { r = it - IT_MT; kindt = 2; } else { r = it - IT_A64; kindt = 3; }
            const int g = (kindt == 2) ? r / 65 : (kindt == 3 ? r : r >> 6), sub = (kindt == 2) ? r % 65 : (r & 63), p = lane;
            const float lr = FIN(7)[g * 64 + p], li = FIN(8)[g * 64 + p], dt = expf(FIN(9)[g]);
            if (kindt == 3) { float er, ei; abar_pow(lr, li, dt, 64, er, ei); float* a = wsp<float>(F, WS_A64) + (g * 64 + p) * 2; a[0] = er; a[1] = ei; continue; }
            float fr, fi; zoh_f(lr, li, dt, fr, fi);
            if (kindt == 0) {
                const int j = sub; float er, ei; abar_pow(lr, li, dt, 63 - j, er, ei);
                float re[16], im[16];
#pragma unroll
                for (int c = 0; c < 16; ++c) { const float br = FIN(10)[(g * 64 + p) * 16 + c], bi = FIN(11)[(g * 64 + p) * 16 + c]; const float bbr = fr * br - fi * bi, bbi = fr * bi + fi * br;
                    re[c] = er * bbr - ei * bbi; im[c] = er * bbi + ei * bbr; }
                bf16* P = wsp<bf16>(F, WS_PTAB) + (size_t)g * 128 * 1024;
                u32x4 w0, w1; w0.x = pk2(re[0], re[1]); w0.y = pk2(re[2], re[3]); w0.z = pk2(re[4], re[5]); w0.w = pk2(re[6], re[7]); w1.x = pk2(re[8], re[9]); w1.y = pk2(re[10], re[11]); w1.z = pk2(re[12], re[13]); w1.w = pk2(re[14], re[15]);
                *(u32x4*)(P + (size_t)p * 1024 + j * 16) = w0; *(u32x4*)(P + (size_t)p * 1024 + j * 16 + 8) = w1;
                w0.x = pk2(im[0], im[1]); w0.y = pk2(im[2], im[3]); w0.z = pk2(im[4], im[5]); w0.w = pk2(im[6], im[7]); w1.x = pk2(im[8], im[9]); w1.y = pk2(im[10], im[11]); w1.z = pk2(im[12], im[13]); w1.w = pk2(im[14], im[15]);
                *(u32x4*)(P + (size_t)(64 + p) * 1024 + j * 16) = w0; *(u32x4*)(P + (size_t)(64 + p) * 1024 + j * 16 + 8) = w1;
            } else if (kindt == 1) {
                const int t = sub; float er, ei; abar_pow(lr, li, dt, t + 1, er, ei);
                bf16* R = wsp<bf16>(F, WS_RTAB) + (size_t)g * 1024 * 128;
#pragma unroll 4
                for (int c = 0; c < 16; ++c) { const float cr = FIN(12)[(g * 16 + c) * 64 + p], ci = FIN(13)[(g * 16 + c) * 64 + p];
                    R[(size_t)(t * 16 + c) * 128 + p] = (bf16)f2bf(cr * er - ci * ei); R[(size_t)(t * 16 + c) * 128 + 64 + p] = (bf16)f2bf(-(cr * ei + ci * er)); }
            } else {
                const int dd = sub; bf16* M = wsp<bf16>(F, WS_MTAB) + ((size_t)g * 65 + dd) * 256;
                if (dd == 0) { for (int k = 0; k < 4; ++k) M[lane + 64 * k] = 0; continue; }
                float er, ei; abar_pow(lr, li, dt, dd - 1, er, ei);
                float X[16], Y[16];
#pragma unroll
                for (int c = 0; c < 16; ++c) { const float br = FIN(10)[(g * 64 + p) * 16 + c], bi = FIN(11)[(g * 64 + p) * 16 + c]; const float bbr = fr * br - fi * bi, bbi = fr * bi + fi * br;
                    X[c] = er * bbr - ei * bbi; Y[c] = er * bbi + ei * bbr; }
#pragma unroll 2
                for (int c = 0; c < 16; ++c) { const float cr = FIN(12)[(g * 16 + c) * 64 + p], ci = FIN(13)[(g * 16 + c) * 64 + p];
                    float t[16];
#pragma unroll
                    for (int c2 = 0; c2 < 16; ++c2) t[c2] = cr * X[c2] - ci * Y[c2];
#pragma unroll
                    for (int st = 0; st < 4; ++st) { const int half = 8 >> st, bit = 32 >> st; const bool up = (lane & bit) != 0;
#pragma unroll
                        for (int i = 0; i < 8; ++i) if (i < half) { const float mine = up ? t[i + half] : t[i], other = up ? t[i] : t[i + half]; t[i] = mine + __shfl_xor(other, bit); } }
                    float tot = t[0]; tot += __shfl_xor(tot, 2); tot += __shfl_xor(tot, 1);
                    if ((lane & 3) == 0) M[c * 16 + ((lane >> 2) & 15)] = (bf16)f2bf(tot); }
            }
        }
    }
}

__device__ __forceinline__ int crow(int r, int hi) { return (r & 3) + 8 * (r >> 2) + 4 * hi; }
constexpr float LOG2E = 1.4426950408889634f;
constexpr float ATTN_DEAD = -160.f;
template <bool EARLY_EXIT>
__device__ __forceinline__ void attn_tile(const bf16* __restrict__ QH, const bf16* __restrict__ KH, const bf16* __restrict__ VT, bf16* __restrict__ O, int bh, int qt, int lane) {
    const int r32 = lane & 31, hi = lane >> 5;
    const bf16* Qp = QH + ((size_t)bh * SEQ + qt * 32 + r32) * HD + hi * 8;
    bf16x8 qf[4];
#pragma unroll
    for (int ks = 0; ks < 4; ++ks) qf[ks] = *(const bf16x8*)(Qp + ks * 16);
    bf16x8 tri[2];
#pragma unroll
    for (int s = 0; s < 2; ++s)
#pragma unroll
        for (int jj = 0; jj < 8; ++jj) { const int jp = 16 * s + 8 * (jj >> 2) + 4 * hi + (jj & 3); tri[s][jj] = (jp > r32) ? (short)0x3f80 : (short)0; }
    f32x16 oT[2]; oT[0] = f32x16{}; oT[1] = f32x16{};
    float R = 0.f;
#define ATT_LOAD(KB, KF, VF) do { const bf16* Kp_ = KH + ((size_t)bh * SEQ + (KB) * 32 + r32) * HD + hi * 8; \
        _Pragma("unroll") for (int ks = 0; ks < 4; ++ks) KF[ks] = *(const bf16x8*)(Kp_ + ks * 16); \
        _Pragma("unroll") for (int mt = 0; mt < 2; ++mt) { const bf16* Vp_ = VT + ((size_t)bh * HD + 32 * mt + r32) * SEQ + (KB) * 32 + 4 * hi; \
            const u32x2 a0 = *(const u32x2*)(Vp_), a1 = *(const u32x2*)(Vp_ + 8), a2 = *(const u32x2*)(Vp_ + 16), a3 = *(const u32x2*)(Vp_ + 24); \
            VF[mt][0] = (u32x4){a0.x, a0.y, a1.x, a1.y}; VF[mt][1] = (u32x4){a2.x, a2.y, a3.x, a3.y}; } } while (0)
    bf16x8 kf[4], kn[4]; u32x4 vf[2][2], vn[2][2];
    ATT_LOAD(qt, kf, vf);
    for (int kb = qt; kb >= 0; --kb) {
        if (kb > 0) { ATT_LOAD(kb - 1, kn, vn); }
        f32x16 st = f32x16{};
#pragma unroll
        for (int ks = 0; ks < 4; ++ks) st = __builtin_amdgcn_mfma_f32_32x32x16_bf16(kf[ks], qf[ks], st, 0, 0, 0);
        f32x16 sp, lg;
        const bool diag = (kb == qt);
#pragma unroll
        for (int r = 0; r < 16; ++r) {
            const float z = st[r]; const float e = __builtin_amdgcn_exp2f(-__builtin_fabsf(z)); const float l2 = __builtin_amdgcn_logf(1.f + e);
            float s_ = __builtin_fmaxf(z, 0.f) + l2, g_ = __builtin_fminf(z, 0.f) - l2;
            if (diag && crow(r, hi) >= r32) { s_ = 0.f; g_ = -1e30f; }
            sp[r] = s_; lg[r] = g_;
        }
        f32x16 later;
#pragma unroll
        for (int r = 0; r < 16; ++r) later[r] = R;
        {
            u32x4 w0, w1;
            w0.x = pk2(-sp[0], -sp[1]); w0.y = pk2(-sp[2], -sp[3]); w0.z = pk2(-sp[4], -sp[5]); w0.w = pk2(-sp[6], -sp[7]);
            w1.x = pk2(-sp[8], -sp[9]); w1.y = pk2(-sp[10], -sp[11]); w1.z = pk2(-sp[12], -sp[13]); w1.w = pk2(-sp[14], -sp[15]);
            later = __builtin_amdgcn_mfma_f32_32x32x16_bf16(tri[0], __builtin_bit_cast(bf16x8, w0), later, 0, 0, 0);
            later = __builtin_amdgcn_mfma_f32_32x32x16_bf16(tri[1], __builtin_bit_cast(bf16x8, w1), later, 0, 0, 0);
        }
        u32x4 p0, p1;
        {
            float w[16];
#pragma unroll
            for (int r = 0; r < 16; ++r) w[r] = __builtin_amdgcn_exp2f(lg[r] + later[r]);
            p0.x = pk2(w[0], w[1]); p0.y = pk2(w[2], w[3]); p0.z = pk2(w[4], w[5]); p0.w = pk2(w[6], w[7]);
            p1.x = pk2(w[8], w[9]); p1.y = pk2(w[10], w[11]); p1.z = pk2(w[12], w[13]); p1.w = pk2(w[14], w[15]);
        }
#pragma unroll
        for (int mt = 0; mt < 2; ++mt) {
            oT[mt] = __builtin_amdgcn_mfma_f32_32x32x16_bf16(__builtin_bit_cast(bf16x8, vf[mt][0]), __builtin_bit_cast(bf16x8, p0), oT[mt], 0, 0, 0);
            oT[mt] = __builtin_amdgcn_mfma_f32_32x32x16_bf16(__builtin_bit_cast(bf16x8, vf[mt][1]), __builtin_bit_cast(bf16x8, p1), oT[mt], 0, 0, 0);
        }
        R = __shfl(later[0] - sp[0], r32);
        if (EARLY_EXIT) { if (__all(R < ATTN_DEAD)) break; }
#pragma unroll
        for (int ks = 0; ks < 4; ++ks) kf[ks] = kn[ks];
#pragma unroll
        for (int mt = 0; mt < 2; ++mt) { vf[mt][0] = vn[mt][0]; vf[mt][1] = vn[mt][1]; }
    }
#undef ATT_LOAD
    bf16* Op = O + ((size_t)(bh >> 3) * SEQ + qt * 32 + r32) * 512 + (bh & 7) * HD + 4 * hi;
#pragma unroll
    for (int mt = 0; mt < 2; ++mt)
#pragma unroll
        for (int q = 0; q < 4; ++q) { u32x2 w; w.x = pk2(oT[mt][4 * q], oT[mt][4 * q + 1]); w.y = pk2(oT[mt][4 * q + 2], oT[mt][4 * q + 3]); *(u32x2*)(Op + 32 * mt + 8 * q) = w; }
}
constexpr int SSM_U = 0, SSM_MT = 65536, SSM_SLOC = SSM_MT + 33280, SSM_SPREV = SSM_SLOC + 16384, SSM_END = SSM_SPREV + 8192;
static_assert(SSM_END <= RING_BYTES, "ssm lds");
__device__ __forceinline__ void ssm_item(Frame& F, int b, int g) {
    LAS unsigned char* lds = F.lds; const int tid = fresh_tid(), lane = tid & 63, w = F.wave;
    const bf16* U = wsp<bf16>(F, WS_U);
#pragma unroll
    for (int i = 0; i < 8; ++i) { const int q = tid + 512 * i, row = q >> 1, half = q & 1, n = row >> 6, j = row & 63;
        *(LAS u32x4*)(lds + SSM_U + ((j * 32 + n) * 16 + half * 8) * 2) = *(const u32x4*)(U + ((size_t)(b * SEQ + row)) * 512 + g * 16 + half * 8); }
    { const u32x4* src = (const u32x4*)(wsp<bf16>(F, WS_MTAB) + (size_t)g * 65 * 256);
      for (int q = tid; q < 2080; q += 512) *(LAS u32x4*)(lds + SSM_MT + q * 16) = src[q]; }
    __syncthreads();
    const int fr = lane & 15, fq = lane >> 4;
    {
        f32x4 a0 = (f32x4){0.f, 0.f, 0.f, 0.f}, a1 = a0;
        const bf16* Pg = wsp<bf16>(F, WS_PTAB) + (size_t)g * 128 * 1024 + (size_t)(16 * w + fr) * 1024 + 8 * fq;
#pragma unroll 4
        for (int j0 = 0; j0 < 32; ++j0) {
            const bf16x8 af = *(const bf16x8*)(Pg + 32 * j0);
            const int ub = SSM_U + (((2 * j0 + (lane >> 5)) * 32 + fr) * 16 + 8 * (fq & 1)) * 2;
            const bf16x8 b0 = *(const LAS bf16x8*)(lds + ub), b1 = *(const LAS bf16x8*)(lds + ub + 16 * 32);
            a0 = __builtin_amdgcn_mfma_f32_16x16x32_bf16(af, b0, a0, 0, 0, 0); a1 = __builtin_amdgcn_mfma_f32_16x16x32_bf16(af, b1, a1, 0, 0, 0);
        }
        LAS float* SL = (LAS float*)(lds + SSM_SLOC);
#pragma unroll
        for (int r = 0; r < 4; ++r) { SL[(16 * w + 4 * fq + r) * 32 + fr] = a0[r]; SL[(16 * w + 4 * fq + r) * 32 + 16 + fr] = a1[r]; }
    }
    __syncthreads();
    if (tid < 64) {
        const int p = tid; const float* a = wsp<float>(F, WS_A64) + (g * 64 + p) * 2; const float ar = a[0], ai = a[1];
        const LAS float* SL = (const LAS float*)(lds + SSM_SLOC); LAS bf16* SP = (LAS bf16*)(lds + SSM_SPREV);
        float sr = 0.f, si = 0.f;
#pragma unroll 4
        for (int n = 0; n < 32; ++n) { SP[n * 128 + p] = (bf16)f2bf(sr); SP[n * 128 + 64 + p] = (bf16)f2bf(si);
            const float lr_ = SL[p * 32 + n], li_ = SL[(64 + p) * 32 + n]; const float nr = ar * sr - ai * si + lr_, ni = ar * si + ai * sr + li_; sr = nr; si = ni; }
    }
    __syncthreads();
    f32x4 acc[8][2];
#pragma unroll
    for (int i = 0; i < 8; ++i) { acc[i][0] = (f32x4){0.f, 0.f, 0.f, 0.f}; acc[i][1] = acc[i][0]; }
#pragma unroll 1
    for (int j0 = 0; j0 < 32; ++j0) {
        const int ub = SSM_U + (((2 * j0 + (lane >> 5)) * 32 + fr) * 16 + 8 * (fq & 1)) * 2;
        const bf16x8 b0 = *(const LAS bf16x8*)(lds + ub), b1 = *(const LAS bf16x8*)(lds + ub + 16 * 32);
#pragma unroll
        for (int i = 0; i < 8; ++i) { const int t = w + 8 * i;
            if (2 * j0 <= t) { const int dd = t - 2 * j0 - (lane >> 5) + 1;
                const bf16x8 af = *(const LAS bf16x8*)(lds + SSM_MT + (dd * 256 + fr * 16 + 8 * (fq & 1)) * 2);
                acc[i][0] = __builtin_amdgcn_mfma_f32_16x16x32_bf16(af, b0, acc[i][0], 0, 0, 0); acc[i][1] = __builtin_amdgcn_mfma_f32_16x16x32_bf16(af, b1, acc[i][1], 0, 0, 0); } }
    }
    {
        const bf16* Rg = wsp<bf16>(F, WS_RTAB) + (size_t)g * 1024 * 128;
#pragma unroll
        for (int ks = 0; ks < 4; ++ks) {
            const int sb = SSM_SPREV + (fr * 128 + 32 * ks + 8 * fq) * 2;
            const bf16x8 b0 = *(const LAS bf16x8*)(lds + sb), b1 = *(const LAS bf16x8*)(lds + sb + 16 * 128 * 2);
#pragma unroll
            for (int i = 0; i < 8; ++i) { const int t = w + 8 * i; const bf16x8 af = *(const bf16x8*)(Rg + (size_t)(t * 16 + fr) * 128 + 32 * ks + 8 * fq);
                acc[i][0] = __builtin_amdgcn_mfma_f32_16x16x32_bf16(af, b0, acc[i][0], 0, 0, 0); acc[i][1] = __builtin_amdgcn_mfma_f32_16x16x32_bf16(af, b1, acc[i][1], 0, 0, 0); }
        }
    }
    {
        const f32x4 dsk = *(const f32x4*)(FIN(14) + g * 16 + 4 * fq); bf16* YG = wsp<bf16>(F, WS_YG);
#pragma unroll
        for (int i = 0; i < 8; ++i) { const int t = w + 8 * i;
#pragma unroll
            for (int ng = 0; ng < 2; ++ng) { const int n = 16 * ng + fr; const u32x2 uw = *(const LAS u32x2*)(lds + SSM_U + ((t * 32 + n) * 16 + 4 * fq) * 2);
                const f32x4 uv = (f32x4){bflo(uw.x), bfhi(uw.x), bflo(uw.y), bfhi(uw.y)}; f32x4 y = acc[i][ng] + dsk * uv;
#pragma unroll
                for (int r = 0; r < 4; ++r) { const float v = y[r]; y[r] = v * sigm(1.5957691216057308f * (v + 0.044715f * v * v * v)); }
                u32x2 o; o.x = pk2(y[0], y[1]); o.y = pk2(y[2], y[3]);
                *(u32x2*)(YG + ((size_t)(b * SEQ + n * 64 + t)) * 512 + g * 16 + 4 * fq) = o; } }
    }
    __syncthreads();
}

constexpr int RT_SEL = LDSCTL_OFF + 8192;
__device__ __forceinline__ void router_phase(Frame& F, int sub) {
    LAS unsigned char* lds = F.lds; const int tid = fresh_tid(), lane = tid & 63, w = F.wave;
    {   const float* W = FIN(19); const float* gff = FIN(18);
#pragma unroll
        for (int it = 0; it < 2; ++it) { const int q = tid + 512 * it, c4 = q & 7, chunk = q >> 3;
            f32x4 v[8];
#pragma unroll
            for (int j = 0; j < 8; ++j) v[j] = *(const f32x4*)(W + (size_t)(8 * chunk + j) * 32 + c4 * 4) * gff[8 * chunk + j];
#pragma unroll
            for (int i = 0; i < 4; ++i) { const int e = 4 * c4 + i; unsigned h[8], l[8];
#pragma unroll
                for (int j = 0; j < 8; ++j) { h[j] = f2bf(v[j][i]); l[j] = f2bf(v[j][i] - bflo(h[j])); }
                u32x4 ph, pl; ph.x = h[0] | (h[1] << 16); ph.y = h[2] | (h[3] << 16); ph.z = h[4] | (h[5] << 16); ph.w = h[6] | (h[7] << 16);
                pl.x = l[0] | (l[1] << 16); pl.y = l[2] | (l[3] << 16); pl.z = l[4] | (l[5] << 16); pl.w = l[6] | (l[7] << 16);
                const int addr = e * 2048 + ((chunk ^ (e & 15)) << 4);
                *(LAS u32x4*)(lds + addr) = ph; *(LAS u32x4*)(lds + 65536 + addr) = pl; } } }
    LAS int* hist = (LAS int*)(lds + RT_SEL + 2048); LAS int* base = hist + 32; LAS int* rec = (LAS int*)(lds + RT_SEL);
    if (tid < 32) hist[tid] = 0;
    __syncthreads();
    const float* X2 = wsp<float>(F, WS_X2); bf16* H2 = wsp<bf16>(F, WS_XN);
    const int fr = lane & 15, fq = lane >> 4;
    for (int tb = ((sub & 1) ? NTOK : F.bx); tb < NTOK / 64; tb += F.G) {
        const int tok0 = tb * 64 + w * 8;
        const float* xr = X2 + (size_t)(tok0 + (fr & 7)) * DM + 8 * fq;
        f32x4 acc0 = (f32x4){0.f, 0.f, 0.f, 0.f}, acc1 = acc0; float ss = 0.f;
#pragma unroll 8
        for (int s = 0; s < 32; ++s) {
            const f32x4 x0 = *(const f32x4*)(xr + 32 * s), x1 = *(const f32x4*)(xr + 32 * s + 4);
            ss += (x0[0] * x0[0] + x0[1] * x0[1]) + (x0[2] * x0[2] + x0[3] * x0[3]) + (x1[0] * x1[0] + x1[1] * x1[1]) + (x1[2] * x1[2] + x1[3] * x1[3]);
            unsigned h[8], l[8];
#pragma unroll
            for (int i = 0; i < 4; ++i) { h[i] = f2bf(x0[i]); l[i] = f2bf(x0[i] - bflo(h[i])); h[4 + i] = f2bf(x1[i]); l[4 + i] = f2bf(x1[i] - bflo(h[4 + i])); }
            u32x4 ah, al; ah.x = h[0] | (h[1] << 16); ah.y = h[2] | (h[3] << 16); ah.z = h[4] | (h[5] << 16); ah.w = h[6] | (h[7] << 16);
            al.x = l[0] | (l[1] << 16); al.y = l[2] | (l[3] << 16); al.z = l[4] | (l[5] << 16); al.w = l[6] | (l[7] << 16);
            const bf16x8 ahi = __builtin_bit_cast(bf16x8, ah), alo = __builtin_bit_cast(bf16x8, al);
            const int boff = fr * 2048 + (((4 * s + fq) ^ fr) << 4);
            const bf16x8 bh0 = *(const LAS bf16x8*)(lds + boff), bh1 = *(const LAS bf16x8*)(lds + boff + 16 * 2048);
            const bf16x8 bl0 = *(const LAS bf16x8*)(lds + 65536 + boff), bl1 = *(const LAS bf16x8*)(lds + 65536 + boff + 16 * 2048);
            acc0 = __builtin_amdgcn_mfma_f32_16x16x32_bf16(ahi, bh0, acc0, 0, 0, 0); acc0 = __builtin_amdgcn_mfma_f32_16x16x32_bf16(alo, bh0, acc0, 0, 0, 0); acc0 = __builtin_amdgcn_mfma_f32_16x16x32_bf16(ahi, bl0, acc0, 0, 0, 0);
            acc1 = __builtin_amdgcn_mfma_f32_16x16x32_bf16(ahi, bh1, acc1, 0, 0, 0); acc1 = __builtin_amdgcn_mfma_f32_16x16x32_bf16(alo, bh1, acc1, 0, 0, 0); acc1 = __builtin_amdgcn_mfma_f32_16x16x32_bf16(ahi, bl1, acc1, 0, 0, 0);
        }
        ss += __shfl_xor(ss, 16); ss += __shfl_xor(ss, 32);
        const float rs = rsqrtf(ss * (1.f / DM) + EPS);
        const float b0 = FIN(20)[fr], b1 = FIN(20)[16 + fr];
        float my_v[4], sv0[4], den[4]; int my_e[4];
#pragma unroll
        for (int r = 0; r < 4; ++r) {
            const float rt = __shfl(rs, (4 * fq + r) & 7);
            float v0 = acc0[r] * rt + b0, v1 = acc1[r] * rt + b1; my_v[r] = 0.f; my_e[r] = 0; den[r] = 0.f; sv0[r] = 0.f;
#pragma unroll
            for (int q = 0; q < 4; ++q) {
                float bv; int bi; if (v0 >= v1) { bv = v0; bi = fr; } else { bv = v1; bi = 16 + fr; }
#pragma unroll
                for (int o = 1; o < 16; o <<= 1) { const float ov = __shfl_xor(bv, o); const int oi = __shfl_xor(bi, o); if (ov > bv || (ov == bv && oi < bi)) { bv = ov; bi = oi; } }
                if (q == 0) sv0[r] = bv;
                den[r] += __expf(bv - sv0[r]);
                if (fr == q) { my_v[r] = bv; my_e[r] = bi; }
                if (bi == fr) v0 = -INFINITY; if (bi == 16 + fr) v1 = -INFINITY;
            }
        }
        if (fq < 2 && fr < 4) {
#pragma unroll
            for (int r = 0; r < 4; ++r) { const int tl = w * 8 + 4 * fq + r, tok = tb * 64 + tl; const int e = my_e[r];
                const int rank = __hip_atomic_fetch_add(hist + e, 1, __ATOMIC_RELAXED, __HIP_MEMORY_SCOPE_WORKGROUP);
                rec[tl * 4 + fr] = (e << 16) | rank; wsp<float>(F, WS_TOPW)[tok * 4 + fr] = __expf(my_v[r] - sv0[r]) / den[r]; }
        }
#pragma unroll 4
        for (int tt = 0; tt < 8; ++tt) { const float rt = __shfl(rs, tt); const int tok = tok0 + tt;
#pragma unroll
            for (int j = 0; j < 4; ++j) { const f32x4 x = *((const f32x4*)(X2 + (size_t)tok * DM) + lane + 64 * j); const f32x4 g = *((const f32x4*)FIN(18) + lane + 64 * j);
                u32x2 o; o.x = pk2(x[0] * rt * g[0], x[1] * rt * g[1]); o.y = pk2(x[2] * rt * g[2], x[3] * rt * g[3]); *((u32x2*)(H2 + (size_t)tok * DM) + lane + 64 * j) = o; } }
        __syncthreads();
        if (tid < 32) { base[tid] = (int)atomicAdd((unsigned*)(F.ctl + CW_CNT + tid), (unsigned)hist[tid]); }
        __syncthreads();
        if (tid < 256) { const int rc = rec[tid], e = rc >> 16, rank = rc & 0xffff; wsp<int>(F, WS_LIST)[e * CAP + base[e] + rank] = (tb * 64 + (tid >> 2)) * 4 + (tid & 3); }
        __syncthreads();
        if (tid < 32) hist[tid] = 0;
        __syncthreads();
    }
}

__device__ __forceinline__ void combine_phase(Frame& F) {
    const int lane = fresh_tid() & 63, gw = F.bx * NWAVES + F.wave, NGW = F.G * NWAVES;
    const float* X2 = wsp<float>(F, WS_X2); const bf16* YS = wsp<bf16>(F, WS_YS); const float* TW = wsp<float>(F, WS_TOPW); bf16* H3 = wsp<bf16>(F, WS_XN);
    for (int tok = gw; tok < NTOK; tok += NGW) {
        const f32x4 tw = *(const f32x4*)(TW + tok * 4);
        f32x4 v[4]; float s = 0.f;
#pragma unroll
        for (int j = 0; j < 4; ++j) { v[j] = *((const f32x4*)(X2 + (size_t)tok * DM) + lane + 64 * j);
#pragma unroll
            for (int k = 0; k < 4; ++k) { const u32x2 yw = *((const u32x2*)(YS + ((size_t)tok * 4 + k) * DM) + lane + 64 * j); const float wk = tw[k];
                v[j].x += wk * bflo(yw.x); v[j].y += wk * bfhi(yw.x); v[j].z += wk * bflo(yw.y); v[j].w += wk * bfhi(yw.y); }
            s += (v[j].x * v[j].x + v[j].y * v[j].y) + (v[j].z * v[j].z + v[j].w * v[j].w);
            *((f32x4*)(F.out + (size_t)tok * DM) + lane + 64 * j) = v[j]; }
        const float r = rsqrtf(wave_sum(s) * (1.f / DM) + EPS);
#pragma unroll
        for (int j = 0; j < 4; ++j) { const f32x4 g = *((const f32x4*)FIN(25) + lane + 64 * j); u32x2 o; o.x = pk2(v[j].x * r * g.x, v[j].y * r * g.y); o.y = pk2(v[j].z * r * g.z, v[j].w * r * g.w);
            *((u32x2*)(H3 + (size_t)tok * DM) + lane + 64 * j) = o; }
    }
}
constexpr int NPHASE = 11;
constexpr int MOE_TST = LDSCTL_OFF + 4096;
struct Args { const float* in[29]; float* out; unsigned char* ws; int ph_lo, ph_hi, sub, pad; };
__global__ void __launch_bounds__(NWAVES * 64, 2) mega_fwd(Args args) {
    extern __shared__ __attribute__((aligned(16))) unsigned char lds_raw[];
    Frame F;
    F.lds = (LAS unsigned char*)lds_raw; F.tid = threadIdx.x; F.lane = F.tid & 63; F.wave = __builtin_amdgcn_readfirstlane(F.tid >> 6); F.G = gridDim.x; F.bx = blockIdx.x;
    F.ws = args.ws; F.out = args.out; F.ctl = (gu32*)(args.ws + WS_CTL);
    for (int u = F.tid; u < (LDS_BYTES - LDSCTL_OFF) / 4; u += NWAVES * 64) ((LAS unsigned*)(F.lds + LDSCTL_OFF))[u] = 0u;
    __syncthreads();
    if (F.tid < 29) ((LAS unsigned long long*)(F.lds + PTAB_OFF))[F.tid] = ((const unsigned long long*)__builtin_amdgcn_kernarg_segment_ptr())[F.tid];
    __syncthreads();
    volatile LAS unsigned* MISC = (volatile LAS unsigned*)(F.lds + MISC_OFF);
    XcdBarrier bar = xcd_barrier_post((unsigned*)(F.ctl + CW_BAR), MISC + 8);
    const int lo = args.ph_lo, hi = args.ph_hi, sub = args.sub;
#ifndef PH_MASK
#define PH_MASK 0xffff
#endif
#define IN_(k) (((PH_MASK >> (k)) & 1) && lo <= (k) && (k) < hi)
#define SEAM(k) do { if (IN_(k) && IN_((k) + 1)) xcd_barrier(bar); } while (0)
    LAS int* tst = (LAS int*)(F.lds + MOE_TST); LAS int* ecnt = tst + 33;

    if (IN_(0)) { p0_prologue(F, sub); } SEAM(0);
    if (IN_(1)) {
        { pg8::Gemm g{wsp<bf16>(F, WS_XN), wsp<bf16>(F, WS_WIN), 1024}; pg8::StaticOrder S; S.init(NTOK, INC, F.G, F.bx);
          epi::EpiInProj E{wsp<bf16>(F, WS_QH), wsp<bf16>(F, WS_KH), wsp<bf16>(F, WS_VT), wsp<bf16>(F, WS_U), wsp<bf16>(F, WS_SGA), wsp<bf16>(F, WS_SGS), FIN(4), FIN(5)};
          pg8::gemm_phase<epi::EpiInProj, pg8::StaticOrder, false>(F.lds, g, S, E); }
        { pg8::Gemm g{wsp<bf16>(F, WS_PBF), wsp<bf16>(F, WS_WPP), 256}; pg8::StaticOrder S; S.init(NTOK, DM, F.G, F.bx);
          epi::EpiPle E{wsp<bf16>(F, WS_PP), wsp<float>(F, WS_PSS)};
          pg8::gemm_phase<epi::EpiPle, pg8::StaticOrder, false>(F.lds, g, S, E); }
    } SEAM(1);
    if (IN_(2)) {
        if (!(sub & 1)) for (int it = F.bx; it < NBATCH * 32; it += F.G) ssm_item(F, it >> 5, it & 31);
        const int gw = F.bx * NWAVES + F.wave, NGW = F.G * NWAVES, alane = fresh_tid() & 63;
        if (!(sub & 2)) for (int it = gw; it < 64 * 32; it += NGW) { const int bh = it >> 5, q = it & 31;
            attn_tile<true>(wsp<bf16>(F, WS_QH), wsp<bf16>(F, WS_KH), wsp<bf16>(F, WS_VT), wsp<bf16>(F, WS_O), bh, q, alane);
            attn_tile<true>(wsp<bf16>(F, WS_QH), wsp<bf16>(F, WS_KH), wsp<bf16>(F, WS_VT), wsp<bf16>(F, WS_O), bh, 63 - q, alane); }
    } SEAM(2);
    if (IN_(3)) {
        pg8::StaticOrder S3; S3.init(NTOK, DM, F.G, F.bx);
        { pg8::Gemm g{wsp<bf16>(F, WS_O), wsp<bf16>(F, WS_WAB), 512};
          epi::EpiT1 E{wsp<bf16>(F, WS_SGA), wsp<bf16>(F, WS_T1)}; pg8::gemm_phase<epi::EpiT1, pg8::StaticOrder, false>(F.lds, g, S3, E); }
        { pg8::Gemm g{wsp<bf16>(F, WS_YG), wsp<bf16>(F, WS_WGLU), 512}; pg8::PairOrder S{S3};
          epi::EpiGlu E{wsp<bf16>(F, WS_T1), wsp<bf16>(F, WS_SGS), FIN(16), wsp<bf16>(F, WS_MIX)}; pg8::gemm_phase<epi::EpiGlu, pg8::PairOrder, false>(F.lds, g, S, E); }
    }
    SEAM(4);
    if (IN_(5)) { pg8::Gemm g{wsp<bf16>(F, WS_MIX), wsp<bf16>(F, WS_WOUT), 1024}; pg8::StaticOrder S; S.init(NTOK, DM, F.G, F.bx);
        epi::EpiX2 E{FIN(0), wsp<float>(F, WS_X2)}; pg8::gemm_phase<epi::EpiX2, pg8::StaticOrder, false>(F.lds, g, S, E); } SEAM(5);
    if (IN_(6)) { router_phase(F, sub); } SEAM(6);
    if (IN_(7) || IN_(8)) {
        if (fresh_tid() == 0) { int a = 0; for (int e = 0; e < NE; ++e) { const int c = (int)__hip_atomic_load(F.ctl + CW_CNT + e, RLX_AGENT); ecnt[e] = c; tst[e] = a; a += (c + 255) >> 8; } tst[32] = a; }
        __syncthreads();
    }
    if (IN_(7)) { pg8::Gemm g{wsp<bf16>(F, WS_XN), wsp<bf16>(F, WS_WUP), 1024}; pg8::MoeOrder S{tst, ecnt, wsp<int>(F, WS_LIST), 8, F.bx, F.G, 2};
        epi::EpiUp E{FIN(22), wsp<bf16>(F, WS_ACT)}; pg8::gemm_phase<epi::EpiUp, pg8::MoeOrder, true>(F.lds, g, S, E); } SEAM(7);
    if (IN_(8)) { pg8::Gemm g{wsp<bf16>(F, WS_ACT), wsp<bf16>(F, WS_WDN), 1024}; pg8::MoeOrder S{tst, ecnt, wsp<int>(F, WS_LIST), 4, F.bx, F.G, 0};
        epi::EpiDown E{FIN(24), wsp<int>(F, WS_LIST), wsp<bf16>(F, WS_YS)}; pg8::gemm_phase<epi::EpiDown, pg8::MoeOrder, false>(F.lds, g, S, E); } SEAM(8);
    if (IN_(9)) { combine_phase(F); } SEAM(9);
    if (IN_(10)) { pg8::Gemm g{wsp<bf16>(F, WS_XN), wsp<bf16>(F, WS_WPG), 1024}; pg8::StaticOrder S; S.init(NTOK, DM, F.G, F.bx);
        epi::EpiFinal E{F.out, wsp<bf16>(F, WS_PP), wsp<float>(F, WS_PSS), FIN(28)}; pg8::gemm_phase<epi::EpiFinal, pg8::StaticOrder, false>(F.lds, g, S, E); }
#undef IN_
#undef SEAM
}

__global__ void g_bf2f(const bf16* src, float* dst, size_t n) { const size_t i = (size_t)blockIdx.x * blockDim.x + threadIdx.x; if (i < n) dst[i] = bflo((unsigned)src[i]); }
__global__ void g_proj(const bf16* QH, const bf16* KH, const bf16* VT, const bf16* U, const bf16* SGA, const bf16* SGS, float* PROJ, int mask) {
    const size_t i = (size_t)blockIdx.x * blockDim.x + threadIdx.x; if (i >= (size_t)NTOK * INC) return;
    const int t = (int)(i >> 12), c = (int)(i & 4095), b = t >> 11, s = t & 2047; float v;
    { const int sec = c < 512 ? 0 : c < 1024 ? 1 : c < 1536 ? 2 : c < 2048 ? 3 : c < 3072 ? 4 : 5; if (!((mask >> sec) & 1)) return; }
    if (c < 512) { const int h = c >> 6, d = c & 63; v = bflo(QH[((size_t)(b * 8 + h) * SEQ + s) * 64 + d]) * (1.f / LOG2E); }
    else if (c < 1024) { const int cc = c - 512, h = cc >> 6, d = cc & 63; v = bflo(KH[((size_t)(b * 8 + h) * SEQ + s) * 64 + d]); }
    else if (c < 1536) { const int cc = c - 1024; v = bflo(VT[((size_t)b * 512 + cc) * SEQ + s]); }
    else if (c < 2048) v = bflo(U[(size_t)t * 512 + c - 1536]);
    else if (c < 3072) v = bflo(SGA[(size_t)t * 1024 + c - 2048]);
    else v = bflo(SGS[(size_t)t * 1024 + c - 3072]);
    PROJ[i] = v;
}
}

#ifndef HYB
#define HYB 0
#endif
extern "C" void kernel_launch(void* const* d_in, const int* in_sizes, int n_in, void* d_out, int out_size, void* d_ws, size_t ws_size, hipStream_t stream) {
    using namespace mk;
    static int grid = 0;
    if (grid == 0) {
        int dev = 0, cus = 0, per_cu = 0;
        if (hipGetDevice(&dev) != hipSuccess || hipDeviceGetAttribute(&cus, hipDeviceAttributeMultiprocessorCount, dev) != hipSuccess) { fprintf(stderr, "kernel_launch: device query failed\n"); grid = -1; return; }
        if (hipFuncSetAttribute((const void*)mega_fwd, hipFuncAttributeMaxDynamicSharedMemorySize, LDS_BYTES) != hipSuccess) { fprintf(stderr, "kernel_launch: hipFuncSetAttribute failed\n"); grid = -1; return; }
        if (hipOccupancyMaxActiveBlocksPerMultiprocessor(&per_cu, (const void*)mega_fwd, NWAVES * 64, LDS_BYTES) != hipSuccess || per_cu < 1) fprintf(stderr, "kernel_launch: occupancy query says %d\n", per_cu);
        (void)hipGetLastError();
        grid = cus;
        if (ws_size < WS_END) { fprintf(stderr, "kernel_launch: workspace too small\n"); grid = -1; return; }
    }
    if (grid < 0) return;
    hipMemsetAsync((char*)d_ws + WS_CTL, 0, CTL_ZERO_BYTES, stream);
    Args a{};
    for (int i = 0; i < 29; ++i) a.in[i] = (const float*)d_in[i];
    a.out = (float*)d_out; a.ws = (unsigned char*)d_ws;
    const int hyb_hi[6] = {NPHASE, 2, 3, 6, 10, NPHASE};
#ifdef PROBE_PH
#ifndef PROBE_SUB
#define PROBE_SUB 0
#endif
    a.ph_lo = 0; a.ph_hi = PROBE_PH;
    if (PROBE_PH > 0) { hipLaunchKernelGGL(mega_fwd, dim3(grid), dim3(NWAVES * 64), LDS_BYTES, stream, a); hipMemsetAsync((char*)d_ws + WS_CTL + CW_BAR * 4, 0, XCD_BAR_WORDS * 4, stream); }
    a.ph_lo = PROBE_PH; a.ph_hi = PROBE_PH + 1; a.sub = PROBE_SUB;
    hipLaunchKernelGGL(mega_fwd, dim3(grid), dim3(NWAVES * 64), LDS_BYTES, stream, a);
    hipMemsetAsync((char*)d_ws + WS_CTL + CW_BAR * 4, 0, XCD_BAR_WORDS * 4, stream);
    if (PROBE_PH == 6) hipMemsetAsync((char*)d_ws + WS_CTL + CW_CNT * 4, 0, 256, stream);
    a.ph_lo = PROBE_PH; a.ph_hi = NPHASE; a.sub = 0;
    hipLaunchKernelGGL(mega_fwd, dim3(grid), dim3(NWAVES * 64), LDS_BYTES, stream, a);
#else
    a.ph_lo = 0; a.ph_hi = hyb_hi[HYB];
    hipLaunchKernelGGL(mega_fwd, dim3(grid), dim3(NWAVES * 64), LDS_BYTES, stream, a);
#endif
#if HYB != 0
    {
        unsigned char* ws = (unsigned char*)d_ws; float* nPP = (float*)(ws + 720 * MiB); float* nPROJ = (float*)(ws + 64 * MiB);
#ifndef GLUEMASK
#define GLUEMASK 0x7f
#endif
        int gmask = (HYB == 2) ? 0x30 : (GLUEMASK & 0x3f); const int ppg = (GLUEMASK >> 6) & 1;
        if (ppg) hipLaunchKernelGGL(g_bf2f, dim3(NTOK * DM / 256), dim3(256), 0, stream, (const bf16*)(ws + WS_PP), nPP, (size_t)NTOK * DM);
        if (HYB == 1 && gmask != 0x3f) {
            hipLaunchKernelGGL(nv::k_rmsnorm, dim3(NTOK / 4), dim3(256), 0, stream, (const float*)d_in[0], (const float*)d_in[2], (float*)ws, NTOK);
            nv::gemm(stream, (float*)ws, DM, (const float*)d_in[3], INC, nPROJ, INC, NTOK, INC, DM, nullptr, nullptr);
            hipLaunchKernelGGL(nv::k_qknorm, dim3(NTOK * 16 / 256), dim3(256), 0, stream, nPROJ, (const float*)d_in[4], (const float*)d_in[5]);
        }
        if (HYB == 1 || HYB == 2)
            hipLaunchKernelGGL(g_proj, dim3(NTOK * INC / 256), dim3(256), 0, stream, (const bf16*)(ws + WS_QH), (const bf16*)(ws + WS_KH), (const bf16*)(ws + WS_VT), (const bf16*)(ws + WS_U), (const bf16*)(ws + WS_SGA), (const bf16*)(ws + WS_SGS), nPROJ, gmask);
        if (HYB == 2) {
            hipLaunchKernelGGL(g_bf2f, dim3(NTOK * 512 / 256), dim3(256), 0, stream, (const bf16*)(ws + WS_O), (float*)(ws + 320 * MiB), (size_t)NTOK * 512);
            hipLaunchKernelGGL(g_bf2f, dim3(NTOK * 512 / 256), dim3(256), 0, stream, (const bf16*)(ws + WS_YG), (float*)(ws + 352 * MiB), (size_t)NTOK * 512);
        }
        if (HYB == 3) hipMemcpyAsync(ws + 640 * MiB, ws + WS_X2, (size_t)NTOK * DM * 4, hipMemcpyDeviceToDevice, stream);
        nv::forward(d_in, (float*)d_out, ws, stream, HYB, (HYB == 1 && (gmask & 0x30) != 0x30) ? 0 : 1, ppg, (const float*)(ws + 640 * MiB));
    }
#endif
}
```
